# Optimizing an MI355X kernel written in HIP

```python
import math
import numpy as np
import jax
import jax.numpy as jnp
from jax import lax

D_MODEL = 1024
BATCH = 16
SEQ = 256
DEPTH = 2
DEC_BATCH = 8
DEC_SEQ = 1024
PAST_LEN = 512

GRID_W = 64
N_BRANCH = 4
H_A = 4
DK_A = 128
DV_A = 128
CONV_W = 5
CHUNK_A = 64
H_B = 4
DK_B = 64
DV_B = 128
H_C = 4
DK_C = 128
DV_C = 128
CHUNK_C = 16
H_D = 8
DH_D = 64
WIN_R = 8
WIN_C = 16
BRANCH_W = H_A * DV_A
GDN_CONV_CH = 2 * H_A * DK_A + H_A * DV_A
Q_BLOCK = 128
ROPE_BASE = 10000.0
D_FF = ((8 * D_MODEL + 3 * 256 - 1) // (3 * 256)) * 256
EPS = 1e-6
MASK_VALUE = -1e30
F_FLOOR = 1e-30
F32 = jnp.float32
IN_SIZES = (H_A * DK_A, H_A * DK_A, H_A * DV_A, H_A * DV_A, 2 * H_A, 2 * H_A,
            H_B * 2 * DK_B, H_B * 2 * DK_B, H_B * DV_B,
            H_C * DK_C, 2 * H_C * DK_C, H_C * DV_C, H_C * DV_C,
            H_D * DH_D, H_D * DH_D, H_D * DH_D,
            N_BRANCH * D_MODEL)
D_IN = sum(IN_SIZES)

kernel_name = 'hybrid_flow_gdn_diff_hgrn2_na_step'


def _rmsnorm(x, g):
    xf = x.astype(F32)
    y = xf * lax.rsqrt(jnp.mean(xf * xf, axis=-1, keepdims=True) + EPS)
    return (y * g.astype(F32)).astype(x.dtype)


def _l2norm(x):
    return x * lax.rsqrt(jnp.sum(x * x, axis=-1, keepdims=True) + EPS)


def _heads(x, n):
    b, t, _ = x.shape
    return x.reshape(b, t, n, -1).transpose(0, 2, 1, 3)


def _merge_heads(o):
    b, h, t, d = o.shape
    return o.transpose(0, 2, 1, 3).reshape(b, t, h * d)


def _flip(a):
    return jnp.flip(a, axis=2)


def _dwconv_centred(x, w):
    ch, kw = w.shape
    rhs = w.T[:, None, :].astype(x.dtype)
    return lax.conv_general_dilated(x, rhs, window_strides=(1,), padding=[(kw // 2, kw // 2)],
                                    dimension_numbers=('NWC', 'WIO', 'NWC'), feature_group_count=ch)


def _axial_rope(n_tok, dim):
    t = jnp.arange(n_tok)
    n_freq = dim // 4
    inv = ROPE_BASE ** (-jnp.arange(n_freq, dtype=F32) / n_freq)
    ang = jnp.concatenate([(t // GRID_W).astype(F32)[:, None] * inv,
                           (t % GRID_W).astype(F32)[:, None] * inv], axis=-1)
    return jnp.cos(ang), jnp.sin(ang)


def _apply_rope(x, cos, sin):
    xf = x.astype(F32)
    half = xf.shape[-1] // 2
    x1, x2 = xf[..., :half], xf[..., half:]
    return jnp.concatenate([x1 * cos - x2 * sin, x2 * cos + x1 * sin], axis=-1).astype(x.dtype)


def _block_map(fn, q):
    b, h, t = q.shape[:3]
    nb = t // Q_BLOCK
    qb = jnp.moveaxis(q.reshape((b, h, nb, Q_BLOCK) + q.shape[3:]), 2, 0)
    o = jnp.moveaxis(lax.map(fn, qb), 0, 2)
    return o.reshape((b, h, t) + o.shape[4:])


def _softmax_attend(q, k, v):
    scale = q.shape[-1] ** -0.5

    def blk(qi):
        p = jax.nn.softmax(jnp.einsum('bhqd,bhkd->bhqk', qi, k).astype(F32) * scale, axis=-1)
        return jnp.einsum('bhqk,bhkd->bhqd', p, v.astype(F32)).astype(q.dtype)

    return _block_map(blk, q)


def _diff_attend(q, k, v, lam):
    scale = q.shape[-1] ** -0.5

    def blk(qi):
        p = jax.nn.softmax(jnp.einsum('bhqmd,bhkmd->bhmqk', qi, k).astype(F32) * scale, axis=-1)
        pd = p[:, :, 0] - lam * p[:, :, 1]
        return jnp.einsum('bhqk,bhkd->bhqd', pd, v.astype(F32)).astype(q.dtype)

    return _block_map(blk, q)


def _gdn_chunked(q, k, v, g, beta, s0):
    b, h, t, dk = q.shape
    dv = v.shape[-1]
    n = t // CHUNK_A
    q = q.reshape(b, h, n, CHUNK_A, dk)
    k = k.reshape(b, h, n, CHUNK_A, dk)
    v = v.reshape(b, h, n, CHUNK_A, dv)
    beta = beta.reshape(b, h, n, CHUNK_A, 1)
    gc = jnp.cumsum(g.reshape(b, h, n, CHUNK_A), axis=-1)
    tril = jnp.tril(jnp.ones((CHUNK_A, CHUNK_A), bool))
    strict = jnp.tril(jnp.ones((CHUNK_A, CHUNK_A), bool), -1)
    diff = gc[..., :, None] - gc[..., None, :]
    decay = jnp.where(tril, jnp.exp(jnp.where(tril, diff, 0.0)), 0.0)
    kb = k * beta
    lmat = jnp.where(strict, jnp.einsum('bhncd,bhnsd->bhncs', kb, k) * decay, 0.0)
    eye = jnp.eye(CHUNK_A, dtype=F32)
    rhs = jnp.concatenate([v * beta, kb * jnp.exp(gc)[..., None]], axis=-1)
    sol = lax.linalg.triangular_solve(eye + lmat, rhs, left_side=True, lower=True)
    u, w = sol[..., :dv], sol[..., dv:]
    a_intra = jnp.where(tril, jnp.einsum('bhncd,bhnsd->bhncs', q, k) * decay, 0.0)
    q_dec = q * jnp.exp(gc)[..., None]
    k_dec = k * jnp.exp(gc[..., -1:] - gc)[..., None]
    g_last = jnp.exp(gc[..., -1])

    def step(s, xs):
        qd, kd, ui, wi, ai, gl = xs
        v_new = ui - jnp.einsum('bhcd,bhde->bhce', wi, s)
        o = jnp.einsum('bhcd,bhde->bhce', qd, s) + jnp.einsum('bhcs,bhse->bhce', ai, v_new)
        s = s * gl[..., None, None] + jnp.einsum('bhcd,bhce->bhde', kd, v_new)
        return s, o

    xs = tuple(jnp.moveaxis(a, 2, 0) for a in (q_dec, k_dec, u, w, a_intra, g_last))
    s_fin, o = lax.scan(step, s0, xs)
    return jnp.moveaxis(o, 0, 2).reshape(b, h, t, dv), s_fin


def _hgrn_chunked(q, k, v, logf, s0):
    b, h, t, dk = q.shape
    dv = v.shape[-1]
    n = t // CHUNK_C
    q = q.reshape(b, h, n, CHUNK_C, dk)
    k = k.reshape(b, h, n, CHUNK_C, dk)
    v = v.reshape(b, h, n, CHUNK_C, dv)
    bc = jnp.cumsum(logf.reshape(b, h, n, CHUNK_C, dk), axis=3)
    tril = jnp.tril(jnp.ones((CHUNK_C, CHUNK_C), bool))[:, :, None]
    diff = bc[:, :, :, :, None, :] - bc[:, :, :, None, :, :]
    dmat = jnp.where(tril, jnp.exp(jnp.where(tril, diff, 0.0)), 0.0)
    a_intra = jnp.einsum('bhntd,bhnsd,bhntsd->bhnts', q, k, dmat)
    o_intra = jnp.einsum('bhnts,bhnse->bhnte', a_intra, v)
    q_dec = q * jnp.exp(bc)
    k_dec = k * jnp.exp(bc[:, :, :, -1:, :] - bc)
    f_last = jnp.exp(bc[:, :, :, -1, :])

    def step(s, xs):
        qd, kd, vi, fl = xs
        o = jnp.einsum('bhcd,bhde->bhce', qd, s)
        s = s * fl[..., None] + jnp.einsum('bhcd,bhce->bhde', kd, vi)
        return s, o

    xs = tuple(jnp.moveaxis(a, 2, 0) for a in (q_dec, k_dec, v, f_last))
    s_fin, o_inter = lax.scan(step, s0, xs)
    o = o_intra + jnp.moveaxis(o_inter, 0, 2)
    return o.reshape(b, h, t, dv), s_fin


def _gdn_mixer(q, k, v, z, a, bgate, conv_w, a_log, dt_bias, norm_g, s0):
    bsz, t, _ = q.shape
    qkv = jax.nn.silu(_dwconv_centred(jnp.concatenate([q, k, v], axis=-1), conv_w)).astype(F32)
    q, k, v = jnp.split(qkv, [H_A * DK_A, 2 * H_A * DK_A], axis=-1)
    q = _l2norm(_heads(q, H_A)) * DK_A ** -0.5
    k = _l2norm(_heads(k, H_A))
    v = _heads(v, H_A)
    g = -jnp.exp(a_log.astype(F32)) * jax.nn.softplus(a.astype(F32).reshape(bsz, t, 2, H_A) + dt_bias.astype(F32))
    beta = jax.nn.sigmoid(bgate.astype(F32).reshape(bsz, t, 2, H_A))
    g = g.transpose(2, 0, 3, 1)
    beta = beta.transpose(2, 0, 3, 1)
    s0 = s0.astype(F32)
    o_f, s_f = _gdn_chunked(q, k, v, g[0], beta[0], s0[:, 0])
    o_b, s_b = _gdn_chunked(_flip(q), _flip(k), _flip(v), _flip(g[1]), _flip(beta[1]), s0[:, 1])
    o = (o_f + _flip(o_b)).transpose(0, 2, 1, 3)
    o = _rmsnorm(o, norm_g) * jax.nn.silu(z.astype(F32).reshape(bsz, t, H_A, DV_A))
    return o.reshape(bsz, t, H_A * DV_A), jnp.stack([s_f, s_b], axis=1)


def _hgrn_mixer(q, f, i, gate, lb, norm_g, s0):
    bsz, t, _ = q.shape
    q = _heads(jax.nn.silu(q.astype(F32)), H_C)
    v = _heads(i.astype(F32), H_C)
    lb = lb.astype(F32)
    fgate = lb + (1.0 - lb) * jax.nn.sigmoid(f.astype(F32).reshape(bsz, t, 2, H_C * DK_C))
    logf = jnp.log(jnp.maximum(fgate, F_FLOOR))
    logf = logf.reshape(bsz, t, 2, H_C, DK_C).transpose(2, 0, 3, 1, 4)
    k = -jnp.expm1(logf)
    s0 = s0.astype(F32)
    o_f, s_f = _hgrn_chunked(q, k[0], v, logf[0], s0[:, 0])
    o_b, s_b = _hgrn_chunked(_flip(q), _flip(k[1]), _flip(v), _flip(logf[1]), s0[:, 1])
    o = (o_f + _flip(o_b)).transpose(0, 2, 1, 3)
    o = _rmsnorm(o, norm_g) * jax.nn.silu(gate.astype(F32).reshape(bsz, t, H_C, DV_C))
    return o.reshape(bsz, t, H_C * DV_C), jnp.stack([s_f, s_b], axis=1)


def _na_latent(q, k, v, ck, cv, rpb):
    b, h, t, d = q.shape
    rows = t // GRID_W
    wr = min(WIN_R, rows)
    n_ctx = ck.shape[2]
    scale = d ** -0.5
    col = jnp.arange(GRID_W)
    c0 = jnp.clip(col - WIN_C // 2, 0, GRID_W - WIN_C)
    col_ok = (col[None, :] >= c0[:, None]) & (col[None, :] < c0[:, None] + WIN_C)
    dc = jnp.clip(col[None, :] - col[:, None] + WIN_C - 1, 0, 2 * WIN_C - 2)
    mask = jnp.broadcast_to(col_ok[:, None, :], (GRID_W, wr, GRID_W)).reshape(GRID_W, wr * GRID_W)
    rpb = rpb.astype(F32)
    ckf, cvf = ck.astype(F32), cv.astype(F32)

    def row_block(r):
        r0 = jnp.clip(r - wr // 2, 0, rows - wr)
        qi = lax.dynamic_slice_in_dim(q, r * GRID_W, GRID_W, axis=2)
        ki = lax.dynamic_slice_in_dim(k, r0 * GRID_W, wr * GRID_W, axis=2)
        vi = lax.dynamic_slice_in_dim(v, r0 * GRID_W, wr * GRID_W, axis=2)
        dr = r0 + jnp.arange(wr) - r + WIN_R - 1
        bias = rpb[:, dr[None, :, None], dc[:, None, :]].reshape(h, GRID_W, wr * GRID_W)
        s_lat = jnp.einsum('bhqd,bhkd->bhqk', qi, ki).astype(F32) * scale + bias
        s_lat = jnp.where(mask, s_lat, MASK_VALUE)
        s_ctx = jnp.einsum('bhqd,bhkd->bhqk', qi.astype(F32), ckf) * scale
        p = jax.nn.softmax(jnp.concatenate([s_ctx, s_lat], axis=-1), axis=-1)
        o = (jnp.einsum('bhqk,bhkd->bhqd', p[..., :n_ctx], cvf)
             + jnp.einsum('bhqk,bhkd->bhqd', p[..., n_ctx:], vi.astype(F32)))
        return o.astype(q.dtype)

    o = lax.map(row_block, jnp.arange(rows))
    return jnp.moveaxis(o, 0, 2).reshape(b, h, t, d)


def _token_mixers(h, lp, ctx):
    bsz, t, _ = h.shape
    offs = np.cumsum(IN_SIZES)[:-1].tolist()
    (aq, ak, av, az, aa, ab, bq, bk, bv, cq, cf, ci, cg, dq, dk, dv, mg) = jnp.split(h @ lp['w_in'], offs, axis=-1)
    latent = ctx is not None
    if latent:
        st_gdn0, ck_b, cv_b, st_hgrn0, ck_d, cv_d = ctx
    else:
        st_gdn0 = jnp.zeros((bsz, 2, H_A, DK_A, DV_A), F32)
        st_hgrn0 = jnp.zeros((bsz, 2, H_C, DK_C, DV_C), F32)

    o_a, st_gdn = _gdn_mixer(aq, ak, av, az, aa, ab, lp['gdn_conv_w'], lp['gdn_A_log'], lp['gdn_dt_bias'],
                             lp['gdn_norm_g'], st_gdn0)

    q_b = bq.reshape(bsz, t, H_B, 2, DK_B).transpose(0, 2, 1, 3, 4)
    k_b = bk.reshape(bsz, t, H_B, 2, DK_B).transpose(0, 2, 1, 3, 4)
    v_b = _heads(bv, H_B)
    lam_p = lp['diff_lambda'].astype(F32)
    lam = jnp.exp(jnp.sum(lam_p[0] * lam_p[1])) - jnp.exp(jnp.sum(lam_p[2] * lam_p[3])) + lp['lam_init']
    if latent:
        cos, sin = _axial_rope(t, DK_B)
        q_b = _apply_rope(q_b, cos[:, None], sin[:, None])
        keys = jnp.concatenate([ck_b.reshape(bsz, H_B, -1, 2, DK_B).astype(k_b.dtype),
                                _apply_rope(k_b, cos[:, None], sin[:, None])], axis=2)
        vals = jnp.concatenate([cv_b.astype(v_b.dtype), v_b], axis=2)
    else:
        keys, vals = k_b, v_b
    o_b = _diff_attend(q_b, keys, vals, lam)
    o_b = _merge_heads(_rmsnorm(o_b, lp['diff_norm_g']) * (1.0 - lp['lam_init']))

    o_c, st_hgrn = _hgrn_mixer(cq, cf, ci, cg, lp['hgrn_lb'], lp['hgrn_norm_g'], st_hgrn0)

    q_d, k_d, v_d = _heads(dq, H_D), _heads(dk, H_D), _heads(dv, H_D)
    if latent:
        o_d = _na_latent(q_d, k_d, v_d, ck_d, cv_d, lp['na_rpb'])
    else:
        o_d = _softmax_attend(q_d, k_d, v_d)
    o_d = _merge_heads(o_d)

    branches = jnp.stack([o_a.astype(h.dtype), o_b.astype(h.dtype), o_c.astype(h.dtype), o_d.astype(h.dtype)], axis=2)
    proj = jnp.einsum('btnw,nwd->btnd', branches, lp['w_branch'])
    gates = jax.nn.sigmoid(mg.reshape(bsz, t, N_BRANCH, D_MODEL))
    out = jnp.einsum('btnd,btnd->btd', gates, proj) @ lp['w_out']
    new_ctx = None if latent else (st_gdn, k_b.reshape(bsz, H_B, t, 2 * DK_B), v_b, st_hgrn, k_d, v_d)
    return out, new_ctx


def _swiglu(h, wg, wu, wd):
    return (jax.nn.silu(h @ wg) * (h @ wu)) @ wd


def _layer(x, cond, lp, ctx):
    mod = jax.nn.silu(cond) @ lp['w_ada'] + lp['b_ada']
    sh1, sc1, g1, sh2, sc2, g2 = jnp.split(mod[:, None, :], 6, axis=-1)
    h = _rmsnorm(x, lp['norm1_g']) * (1.0 + sc1) + sh1
    mix, new_ctx = _token_mixers(h, lp, ctx)
    x = x + g1 * mix
    h = _rmsnorm(x, lp['norm2_g']) * (1.0 + sc2) + sh2
    x = x + g2 * _swiglu(h, lp['w_ffn_gate'], lp['w_ffn_up'], lp['w_ffn_down'])
    return x, new_ctx


def setup_inputs(seed: int = 0) -> dict:
    key = jax.random.key(seed)
    ks = iter(jax.random.split(key, 40))

    def nrm(shape, s):
        return jax.random.normal(next(ks), shape, jnp.float32) * s

    L = DEPTH
    a_log = jnp.log(jax.random.uniform(next(ks), (L, 2, H_A), jnp.float32, 1.0, 16.0))
    dt = jnp.exp(jax.random.uniform(next(ks), (L, 2, H_A), jnp.float32, math.log(1e-3), math.log(1e-1)))
    return {
        'x_prompt': nrm((BATCH, SEQ, D_MODEL), 1.0),
        'x_sample': nrm((DEC_BATCH, DEC_SEQ, D_MODEL), 1.0),
        'c': nrm((DEC_BATCH, D_MODEL), 1.0),
        'state_gdn': nrm((DEC_BATCH, L, 2, H_A, DK_A, DV_A), 0.1),
        'cache_diff_k': nrm((DEC_BATCH, L, H_B, PAST_LEN, 2 * DK_B), 1.0),
        'cache_diff_v': nrm((DEC_BATCH, L, H_B, PAST_LEN, DV_B), 1.0),
        'state_hgrn': nrm((DEC_BATCH, L, 2, H_C, DK_C, DV_C), 0.1),
        'cache_na_k': nrm((DEC_BATCH, L, H_D, PAST_LEN, DH_D), 1.0),
        'cache_na_v': nrm((DEC_BATCH, L, H_D, PAST_LEN, DH_D), 1.0),
        'c_ctx': nrm((D_MODEL,), 1.0),
        'w_ada': nrm((L, D_MODEL, 6 * D_MODEL), 0.5 * D_MODEL ** -0.5),
        'b_ada': nrm((L, 6 * D_MODEL), 0.02),
        'norm1_g': 1.0 + nrm((L, D_MODEL), 0.1),
        'w_in': nrm((L, D_MODEL, D_IN), D_MODEL ** -0.5),
        'gdn_conv_w': nrm((L, GDN_CONV_CH, CONV_W), CONV_W ** -0.5),
        'gdn_A_log': a_log,
        'gdn_dt_bias': dt + jnp.log(-jnp.expm1(-dt)),
        'gdn_norm_g': 1.0 + nrm((L, DV_A), 0.1),
        'diff_lambda': nrm((L, 4, DK_B), 0.1),
        'diff_norm_g': 1.0 + nrm((L, DV_B), 0.1),
        'hgrn_lb_logits': nrm((L, 2, H_C * DK_C), 1.0),
        'hgrn_norm_g': 1.0 + nrm((L, DV_C), 0.1),
        'na_rpb': nrm((L, H_D, 2 * WIN_R - 1, 2 * WIN_C - 1), 0.1),
        'w_branch': nrm((L, N_BRANCH, BRANCH_W, D_MODEL), BRANCH_W ** -0.5),
        'w_out': nrm((L, D_MODEL, D_MODEL), D_MODEL ** -0.5),
        'norm2_g': 1.0 + nrm((L, D_MODEL), 0.1),
        'w_ffn_gate': nrm((L, D_MODEL, D_FF), D_MODEL ** -0.5),
        'w_ffn_up': nrm((L, D_MODEL, D_FF), D_MODEL ** -0.5),
        'w_ffn_down': nrm((L, D_FF, D_MODEL), D_FF ** -0.5),
        'final_norm_g': 1.0 + nrm((D_MODEL,), 0.1),
    }


def reference(x_prompt, x_sample, c, state_gdn, cache_diff_k, cache_diff_v, state_hgrn, cache_na_k, cache_na_v,
              c_ctx, w_ada, b_ada, norm1_g, w_in, gdn_conv_w, gdn_A_log, gdn_dt_bias, gdn_norm_g,
              diff_lambda, diff_norm_g, hgrn_lb_logits, hgrn_norm_g, na_rpb, w_branch, w_out, norm2_g,
              w_ffn_gate, w_ffn_up, w_ffn_down, final_norm_g):
    probs = jax.nn.softmax(hgrn_lb_logits.astype(F32), axis=0)
    lb_all = jnp.cumsum(probs, axis=0) - probs[0:1]
    xp, xs = x_prompt, x_sample
    ctx_out = []
    for l in range(DEPTH):
        lp = {
            'w_ada': w_ada[l], 'b_ada': b_ada[l], 'norm1_g': norm1_g[l], 'w_in': w_in[l],
            'gdn_conv_w': gdn_conv_w[l], 'gdn_A_log': gdn_A_log[l], 'gdn_dt_bias': gdn_dt_bias[l],
            'gdn_norm_g': gdn_norm_g[l], 'diff_lambda': diff_lambda[l], 'diff_norm_g': diff_norm_g[l],
            'lam_init': 0.8 - 0.6 * math.exp(-0.3 * l), 'hgrn_lb': lb_all[l], 'hgrn_norm_g': hgrn_norm_g[l],
            'na_rpb': na_rpb[l], 'w_branch': w_branch[l], 'w_out': w_out[l], 'norm2_g': norm2_g[l],
            'w_ffn_gate': w_ffn_gate[l], 'w_ffn_up': w_ffn_up[l], 'w_ffn_down': w_ffn_down[l],
        }
        xp, new_l = _layer(xp, c_ctx[None, :], lp, None)
        ctx_out.append(new_l)
        cached = (state_gdn[:, l], cache_diff_k[:, l], cache_diff_v[:, l], state_hgrn[:, l],
                  cache_na_k[:, l], cache_na_v[:, l])
        xs, _ = _layer(xs, c, lp, cached)
    y_prompt = _rmsnorm(xp, final_norm_g)
    y_sample = _rmsnorm(xs, final_norm_g)
    new_state_gdn = jnp.stack([n[0] for n in ctx_out], axis=1)
    new_cache_diff_k = jnp.stack([n[1] for n in ctx_out], axis=1)
    new_cache_diff_v = jnp.stack([n[2] for n in ctx_out], axis=1)
    new_state_hgrn = jnp.stack([n[3] for n in ctx_out], axis=1)
    new_cache_na_k = jnp.stack([n[4] for n in ctx_out], axis=1)
    new_cache_na_v = jnp.stack([n[5] for n in ctx_out], axis=1)
    return (y_prompt, y_sample, new_state_gdn, new_cache_diff_k, new_cache_diff_v, new_state_hgrn, new_cache_na_k, new_cache_na_v)
```

```cpp
#include <hip/hip_runtime.h>
#include <hip/hip_cooperative_groups.h>
#include <cstdio>
#include <cstdint>
namespace cg = cooperative_groups;

#ifndef FUSED
#define FUSED 1
#endif

#define DI __device__ __forceinline__
typedef unsigned short bf16_t;
typedef short bf16x8 __attribute__((ext_vector_type(8)));
typedef short s16x4 __attribute__((ext_vector_type(4)));
typedef float f32x16 __attribute__((ext_vector_type(16)));
typedef unsigned u32x4 __attribute__((ext_vector_type(4)));
typedef unsigned u32x2 __attribute__((ext_vector_type(2)));
typedef float f32x4 __attribute__((ext_vector_type(4)));

constexpr int NTOK = 12288, NCTX = 4096, PS = 7808;
constexpr int C_AQ = 0, C_AK = 512, C_AV = 1024, C_AZ = 1536, C_BQ = 2048, C_BK = 2560, C_BV = 3072, C_CQ = 3584, C_CF = 4096,
              C_CI = 5120, C_CG = 5632, C_DQ = 6144, C_DK = 6656, C_DV = 7168, C_AA = 7680, C_AB = 7688;
constexpr int NPH = 20;
constexpr int SMEM_BYTES = 73728;

constexpr size_t OFF_CTR = 0;
constexpr size_t OFF_MOD = 4096;
constexpr size_t OFF_ROPE = OFF_MOD + (size_t)2 * 9 * 6144 * 4;
constexpr size_t OFF_LB = OFF_ROPE + (size_t)2 * 1024 * 32 * 4;
constexpr size_t OFF_H = OFF_LB + 8192;
constexpr size_t OFF_P = OFF_H + (size_t)NTOK * 1024 * 2;
constexpr size_t OFF_WTIN = OFF_P + (size_t)NTOK * PS * 2;
constexpr size_t OFF_WTBR = OFF_WTIN + (size_t)11904 * 1024 * 2;
constexpr size_t OFF_WTOUT = OFF_WTBR + (size_t)4 * 1024 * 512 * 2;
constexpr size_t OFF_WTGU = OFF_WTOUT + (size_t)1024 * 1024 * 2;
constexpr size_t OFF_WTDN = OFF_WTGU + (size_t)5632 * 1024 * 2;
constexpr size_t OFF_OD = OFF_WTDN + (size_t)1024 * 2816 * 2;
constexpr size_t OFF_VTB = OFF_OD + (size_t)4 * NTOK * 512 * 2;
constexpr size_t OFF_VTD = OFF_VTB + (size_t)NTOK * 512 * 2;
constexpr size_t OFF_VTCB = OFF_VTD + (size_t)NTOK * 512 * 2;
constexpr size_t OFF_VTCD = OFF_VTCB + (size_t)8 * 512 * 512 * 2;
constexpr size_t OFF_BAR = OFF_VTCD + (size_t)8 * 512 * 512 * 2;
constexpr size_t OFF_CUCTR = OFF_BAR + 16384;
constexpr size_t WS_TOTAL = OFF_CUCTR + 65536;
constexpr size_t OFF_M = OFF_OD;
constexpr size_t OFF_G = OFF_P;

constexpr size_t O_SGDN = 12582912, O_DK = 16777216, O_DV = 20971520, O_SHGRN = 25165824, O_NK = 29360128, O_NV = 33554432;

extern __shared__ __attribute__((aligned(16))) char dyn_smem[];

struct Params {
  const float *x_prompt, *x_sample, *c, *state_gdn, *cache_diff_k, *cache_diff_v, *state_hgrn, *cache_na_k, *cache_na_v, *c_ctx,
      *w_ada, *b_ada, *norm1_g, *w_in, *gdn_conv_w, *gdn_A_log, *gdn_dt_bias, *gdn_norm_g, *diff_lambda, *diff_norm_g,
      *hgrn_lb_logits, *hgrn_norm_g, *na_rpb, *w_branch, *w_out, *norm2_g, *w_ffn_gate, *w_ffn_up, *w_ffn_down, *final_norm_g;
  float* out;
  char* ws;
  int ph_lo, ph_hi, use_cg, pad_;
};

typedef __bf16 hbf16x2 __attribute__((ext_vector_type(2)));
DI bf16_t f2bf(float x) { return __builtin_bit_cast(bf16_t, (__bf16)x); }
DI float bf2f(bf16_t v) { return __uint_as_float(((unsigned)v) << 16); }
DI unsigned pack2(float a, float b) { typedef float f2v __attribute__((ext_vector_type(2))); const f2v f = {a, b}; return __builtin_bit_cast(unsigned, __builtin_convertvector(f, hbf16x2)); }
DI float lo2f(unsigned u) { return __uint_as_float(u << 16); }
DI float hi2f(unsigned u) { return __uint_as_float(u & 0xffff0000u); }
DI void unpack8(const u32x4& v, float* x) {
  x[0] = lo2f(v.x); x[1] = hi2f(v.x); x[2] = lo2f(v.y); x[3] = hi2f(v.y);
  x[4] = lo2f(v.z); x[5] = hi2f(v.z); x[6] = lo2f(v.w); x[7] = hi2f(v.w);
}
DI u32x4 pack8(const float* x) { u32x4 v; v.x = pack2(x[0], x[1]); v.y = pack2(x[2], x[3]); v.z = pack2(x[4], x[5]); v.w = pack2(x[6], x[7]); return v; }
DI int get_tid() { int t = threadIdx.x; asm volatile("" : "+v"(t)); return t; }
DI int lrow(int v) { asm volatile("" : "+v"(v)); return v; }
DI float wave_sum(float v) {
#pragma unroll
  for (int o = 32; o > 0; o >>= 1) v += __shfl_xor(v, o);
  return v;
}

typedef float f32x2 __attribute__((ext_vector_type(2)));
template <int CTRL> DI float dpp_mov(float v) { return __builtin_bit_cast(float, __builtin_amdgcn_update_dpp(0, __builtin_bit_cast(int, v), CTRL, 0xF, 0xF, true)); }
DI float red8(float v) { v += dpp_mov<0xB1>(v); v += dpp_mov<0x4E>(v); v += dpp_mov<0x141>(v); return v; }
DI float rdl(float v, int l) { return __builtin_bit_cast(float, __builtin_amdgcn_readlane(__builtin_bit_cast(int, v), l)); }
DI float wave_sum_fast(float v) { v = red8(v); v += dpp_mov<0x140>(v); return (rdl(v, 0) + rdl(v, 16)) + (rdl(v, 32) + rdl(v, 48)); }
DI void ld16(const float* p, f32x2 (&o)[8]) {
#pragma unroll
  for (int i = 0; i < 4; ++i) { const f32x4 a = *(const f32x4*)(p + 4 * i); o[2 * i] = (f32x2){a.x, a.y}; o[2 * i + 1] = (f32x2){a.z, a.w}; }
}
DI unsigned xb_xcc_id();
DI float sigmoidf_(float x) { return __builtin_amdgcn_rcpf(1.f + __expf(-x)); }
DI float siluf_(float x) { return x * __builtin_amdgcn_rcpf(1.f + __expf(-x)); }
DI int crow(int reg, int h) { return (reg & 3) + 8 * (reg >> 2) + 4 * h; }
#define MFMA32(a, b, c) __builtin_amdgcn_mfma_f32_32x32x16_bf16((a), (b), (c), 0, 0, 0)


DI void store_blk_bf16(bf16_t* base, size_t ld, int row0, int col, const f32x16& a, int r, int h) {
  const bool odd = (r & 1) != 0;
  const int colbase = col & ~1;
#pragma unroll
  for (int k = 0; k < 8; ++k) {
    const float lo = a[k], hi = a[k + 8];
    const float recv = dpp_mov<0xB1>(odd ? lo : hi);
    const int row = row0 + crow(odd ? k + 8 : k, h);
    __builtin_nontemporal_store(odd ? pack2(recv, hi) : pack2(lo, recv), (unsigned*)(base + (size_t)row * ld + colbase));
  }
}
template <int MI, int NJ>
DI void gemm_ld(u32x4 (&ra)[2 * MI], u32x4 (&rb)[2 * NJ], const bf16_t* A, int lda, const bf16_t* B, int ldb, int k0, int lr, int lc, int bgs = 32) {
#pragma unroll
  for (int i = 0; i < 2 * MI; ++i) ra[i] = *(const u32x4*)(A + (size_t)(lr + 32 * i) * lda + k0 + lc);
#pragma unroll
  for (int i = 0; i < 2 * NJ; ++i) rb[i] = *(const u32x4*)(B + (size_t)(lr + bgs * i) * ldb + k0 + lc);
}
template <int MI, int NJ>
DI void gemm_st(const u32x4 (&ra)[2 * MI], const u32x4 (&rb)[2 * NJ], bf16_t* As, bf16_t* Bs, int lr, int lc) {
#pragma unroll
  for (int i = 0; i < 2 * MI; ++i) *(u32x4*)(As + (lr + 32 * i) * 72 + lc) = ra[i];
#pragma unroll
  for (int i = 0; i < 2 * NJ; ++i) *(u32x4*)(Bs + (lr + 32 * i) * 72 + lc) = rb[i];
}
template <int MI, int NJ>
DI void gemm_mm(f32x16 (&acc)[MI][NJ], const bf16_t* As, const bf16_t* Bs, int wm, int wn, int r, int h) {
  __builtin_amdgcn_s_setprio(1);
#pragma unroll
  for (int ks = 0; ks < 4; ++ks) {
    bf16x8 a[MI], b[NJ];
#pragma unroll
    for (int i = 0; i < MI; ++i) a[i] = *(const bf16x8*)(As + (wm * 32 * MI + i * 32 + r) * 72 + ks * 16 + h * 8);
#pragma unroll
    for (int j = 0; j < NJ; ++j) b[j] = *(const bf16x8*)(Bs + (wn * 32 * NJ + j * 32 + r) * 72 + ks * 16 + h * 8);
#pragma unroll
    for (int i = 0; i < MI; ++i)
#pragma unroll
      for (int j = 0; j < NJ; ++j) acc[i][j] = MFMA32(a[i], b[j], acc[i][j]);
  }
  __builtin_amdgcn_s_setprio(0);
}
template <int MI, int NJ>
DI void gemm_dma(const bf16_t* A, int lda, const bf16_t* B, int ldb, int k0, char* stage, int tid, int bgs) {
  const int lr = tid >> 3, gch = ((tid & 7) ^ (lr & 7)) * 8;
#pragma unroll
  for (int i = 0; i < 2 * MI; ++i)
    __builtin_amdgcn_global_load_lds((const unsigned*)(A + (size_t)(lr + 32 * i) * lda + k0 + gch), (unsigned*)(stage + tid * 16 + i * 4096), 16, 0, 0);
#pragma unroll
  for (int i = 0; i < 2 * NJ; ++i)
    __builtin_amdgcn_global_load_lds((const unsigned*)(B + (size_t)(lr + bgs * i) * ldb + k0 + gch), (unsigned*)(stage + 64 * MI * 128 + tid * 16 + i * 4096), 16, 0, 0);
}
template <int MI, int NJ>
DI void gemm_mm3(f32x16 (&acc)[MI][NJ], const char* As, const char* Bs, int wm, int wn, int r, int h) {
  __builtin_amdgcn_s_setprio(1);
#pragma unroll
  for (int ks = 0; ks < 4; ++ks) {
    bf16x8 a[MI], b[NJ];
#pragma unroll
    for (int i = 0; i < MI; ++i) { const int R = wm * 32 * MI + i * 32 + r; a[i] = *(const bf16x8*)(As + R * 128 + (((ks * 2 + h) ^ (R & 7)) << 4)); }
#pragma unroll
    for (int j = 0; j < NJ; ++j) { const int R = wn * 32 * NJ + j * 32 + r; b[j] = *(const bf16x8*)(Bs + R * 128 + (((ks * 2 + h) ^ (R & 7)) << 4)); }
#pragma unroll
    for (int i = 0; i < MI; ++i)
#pragma unroll
      for (int j = 0; j < NJ; ++j) acc[i][j] = MFMA32(a[i], b[j], acc[i][j]);
  }
  __builtin_amdgcn_s_setprio(0);
}
template <int MI, int NJ, int MODE = 0>
DI void gemm_kloop(f32x16 (&acc)[MI][NJ], const bf16_t* A, int lda, const bf16_t* B, int ldb, int K, bf16_t* sm, int bgs = 32) {
  const int tid = get_tid(), lane = tid & 63, w = tid >> 6, wm = w >> 1, wn = w & 1, r = lane & 31, h = lane >> 5;
  const int lr = tid >> 3, lc = (tid & 7) * 8;
  const int nk = K >> 6;
  if (MODE == 3) {
    constexpr int STGB = (64 * MI + 64 * NJ) * 128;
    char* smb = (char*)sm;
    __syncthreads();
    gemm_dma<MI, NJ>(A, lda, B, ldb, 0, smb, tid, bgs);
    asm volatile("s_waitcnt vmcnt(0)" ::: "memory");
    __syncthreads();
    for (int kt = 0; kt < nk; ++kt) {
      char* cs = smb + (kt & 1) * STGB;
      if (kt + 1 < nk) gemm_dma<MI, NJ>(A, lda, B, ldb, (kt + 1) * 64, smb + ((kt + 1) & 1) * STGB, tid, bgs);
      gemm_mm3<MI, NJ>(acc, cs, cs + 64 * MI * 128, wm, wn, r, h);
      asm volatile("s_waitcnt vmcnt(0)" ::: "memory");
      __syncthreads();
    }
    return;
  }
  u32x4 ra[2 * MI], rb[2 * NJ];
  gemm_ld<MI, NJ>(ra, rb, A, lda, B, ldb, 0, lr, lc, bgs);
  if (MODE == 2) {
    constexpr int STG = (64 * MI + 64 * NJ) * 72;
    __syncthreads();
    gemm_st<MI, NJ>(ra, rb, sm, sm + 64 * MI * 72, lr, lc);
    if (nk > 1) gemm_ld<MI, NJ>(ra, rb, A, lda, B, ldb, 64, lr, lc, bgs);
    __syncthreads();
    for (int kt = 0; kt < nk; ++kt) {
      bf16_t* cs = sm + (kt & 1) * STG;
      bf16_t* ns = sm + ((kt + 1) & 1) * STG;
      if (kt + 1 < nk) gemm_st<MI, NJ>(ra, rb, ns, ns + 64 * MI * 72, lr, lc);
      if (kt + 2 < nk) gemm_ld<MI, NJ>(ra, rb, A, lda, B, ldb, (kt + 2) * 64, lr, lc, bgs);
      gemm_mm<MI, NJ>(acc, cs, cs + 64 * MI * 72, wm, wn, r, h);
      __syncthreads();
    }
  } else if (MODE == 1) {
    bf16_t* As = sm;
    bf16_t* Bs = sm + 64 * MI * 72;
    u32x4 ra2[2 * MI], rb2[2 * NJ];
    gemm_ld<MI, NJ>(ra2, rb2, A, lda, B, ldb, 64, lr, lc, bgs);
    for (int kt = 0; kt < nk; kt += 2) {
      __syncthreads();
      gemm_st<MI, NJ>(ra, rb, As, Bs, lr, lc);
      __syncthreads();
      if (kt + 2 < nk) gemm_ld<MI, NJ>(ra, rb, A, lda, B, ldb, (kt + 2) * 64, lr, lc, bgs);
      gemm_mm<MI, NJ>(acc, As, Bs, wm, wn, r, h);
      __syncthreads();
      gemm_st<MI, NJ>(ra2, rb2, As, Bs, lr, lc);
      __syncthreads();
      if (kt + 3 < nk) gemm_ld<MI, NJ>(ra2, rb2, A, lda, B, ldb, (kt + 3) * 64, lr, lc, bgs);
      gemm_mm<MI, NJ>(acc, As, Bs, wm, wn, r, h);
    }
  } else {
    bf16_t* As = sm;
    bf16_t* Bs = sm + 64 * MI * 72;
    for (int kt = 0; kt < nk; ++kt) {
      __syncthreads();
      gemm_st<MI, NJ>(ra, rb, As, Bs, lr, lc);
      __syncthreads();
      if (kt + 1 < nk) gemm_ld<MI, NJ>(ra, rb, A, lda, B, ldb, (kt + 1) * 64, lr, lc, bgs);
      gemm_mm<MI, NJ>(acc, As, Bs, wm, wn, r, h);
    }
  }
}

template <int MI, int NJ>
DI void zero_acc(f32x16 (&acc)[MI][NJ]) {
#pragma unroll
  for (int i = 0; i < MI; ++i)
#pragma unroll
    for (int j = 0; j < NJ; ++j)
#pragma unroll
      for (int r = 0; r < 16; ++r) acc[i][j][r] = 0.f;
}

DI bool tile_map(int it, int MT, int NT, int& tm, int& tn) {
  const int xcd = blockIdx.x & 7, local = blockIdx.x >> 3, nloc = gridDim.x >> 3, mper = MT >> 3;
  const int w = local + it * nloc;
  if (w >= mper * NT) return false;
  tn = w / mper;
  tm = xcd * mper + (w % mper);
  return true;
}

DI int cond_of_row(int row) { return row < NCTX ? 8 : ((row - NCTX) >> 10); }

DI void phase_prologue(const Params& p, char* smem) {
  const int tid = get_tid(), lane = tid & 63, w = tid >> 6;
  const int gtid = blockIdx.x * 256 + tid, gsz = gridDim.x * 256;
  float* consts = (float*)(p.ws + OFF_CTR);
  if (blockIdx.x == 0) {
    if (tid < 8) ((unsigned*)consts)[tid] = 0u;
    if (tid >= 32 && tid < 64) ((unsigned*)consts)[tid] = 0u;
    if (w == 1) {
      for (int l = 0; l < 2; ++l) {
        const float* dl = p.diff_lambda + l * 256;
        float a = dl[lane] * dl[64 + lane], b = dl[128 + lane] * dl[192 + lane];
        a = wave_sum(a); b = wave_sum(b);
        const float li = 0.8f - 0.6f * expf(-0.3f * (float)l);
        if (lane == 0) { consts[16 + l] = expf(a) - expf(b) + li; consts[18 + l] = 1.f - li; }
      }
    }
  }
  {
    float* rc = (float*)(p.ws + OFF_ROPE);
    float* rs = rc + 1024 * 32;
    for (int i = gtid; i < 1024 * 32; i += gsz) {
      const int t = i >> 5, pp = i & 31;
      const float inv = powf(10000.f, -(float)(pp & 15) / 16.f);
      const float pos = pp < 16 ? (float)(t >> 6) : (float)(t & 63);
      const float ang = pos * inv;
      rc[i] = cosf(ang); rs[i] = sinf(ang);
    }
  }
  {
    float* LB = (float*)(p.ws + OFF_LB);
    for (int i = gtid; i < 1024; i += gsz) {
      const float x0 = p.hgrn_lb_logits[i], x1 = p.hgrn_lb_logits[1024 + i];
      const float m = fmaxf(x0, x1), e0 = expf(x0 - m), e1 = expf(x1 - m);
      LB[i] = 0.f; LB[1024 + i] = e1 / (e0 + e1);
    }
  }
  {
    float* sc = (float*)smem;
    float* red = sc + 9 * 1024;
    float* MOD = (float*)(p.ws + OFF_MOD);
    bool filled = false;
    for (int item = blockIdx.x; item < 192; item += gridDim.x) {
      if (!filled) {
        for (int i = tid; i < 9 * 1024; i += 256) { const int c = i >> 10, k = i & 1023; const float v = c < 8 ? p.c[c * 1024 + k] : p.c_ctx[k]; sc[i] = siluf_(v); }
        filled = true;
      }
      __syncthreads();
      const int l = item / 96, cg0 = (item % 96) * 64;
      const int kq = tid >> 4, c4 = tid & 15;
      float acc[9][4];
#pragma unroll
      for (int c = 0; c < 9; ++c)
#pragma unroll
        for (int e = 0; e < 4; ++e) acc[c][e] = 0.f;
      const float* wp = p.w_ada + ((size_t)l * 1024 + kq * 64) * 6144 + cg0 + c4 * 4;
#pragma unroll 4
      for (int k = 0; k < 64; ++k) {
        const f32x4 wv = *(const f32x4*)(wp + (size_t)k * 6144);
#pragma unroll
        for (int c = 0; c < 9; ++c) {
          const float s = sc[c * 1024 + kq * 64 + k];
          acc[c][0] += s * wv.x; acc[c][1] += s * wv.y; acc[c][2] += s * wv.z; acc[c][3] += s * wv.w;
        }
      }
#pragma unroll
      for (int c = 0; c < 9; ++c)
#pragma unroll
        for (int e = 0; e < 4; ++e) { float v = acc[c][e]; v += __shfl_xor(v, 16); v += __shfl_xor(v, 32); acc[c][e] = v; }
      if (lane < 16) {
#pragma unroll
        for (int c = 0; c < 9; ++c)
#pragma unroll
          for (int e = 0; e < 4; ++e) red[(w * 9 + c) * 64 + c4 * 4 + e] = acc[c][e];
      }
      __syncthreads();
      for (int i = tid; i < 9 * 64; i += 256) {
        const int c = i >> 6, col = i & 63;
        const float v = red[(0 * 9 + c) * 64 + col] + red[(1 * 9 + c) * 64 + col] + red[(2 * 9 + c) * 64 + col] + red[(3 * 9 + c) * 64 + col];
        MOD[((size_t)l * 9 + c) * 6144 + cg0 + col] = v + p.b_ada[l * 6144 + cg0 + col];
      }
    }
  }
}

DI void phase_norm(const Params& p, int l, int which) {
  const int tid = get_tid(), lane = tid & 63, w = tid >> 6;
  float* X = p.out;
  bf16_t* H = (bf16_t*)(p.ws + OFF_H);
  const float* MOD = (const float*)(p.ws + OFF_MOD);
  for (int it = blockIdx.x; it < NTOK / 4; it += gridDim.x) {
    const int row = it * 4 + w;
    const float* xsrc = (which == 0 && l == 0) ? (row < NCTX ? p.x_prompt + (size_t)row * 1024 : p.x_sample + (size_t)(row - NCTX) * 1024) : X + (size_t)row * 1024;
    f32x4 x[4];
    float ss = 0.f;
#pragma unroll
    for (int i = 0; i < 4; ++i) {
      x[i] = *(const f32x4*)(xsrc + i * 256 + lane * 4);
      ss += x[i].x * x[i].x + x[i].y * x[i].y + x[i].z * x[i].z + x[i].w * x[i].w;
    }
    ss = wave_sum(ss);
    const float rstd = rsqrtf(ss * (1.f / 1024.f) + 1e-6f);
    if (which == 2) {
#pragma unroll
      for (int i = 0; i < 4; ++i) {
        const int col = i * 256 + lane * 4;
        const f32x4 g = *(const f32x4*)(p.final_norm_g + col);
        f32x4 y; y.x = x[i].x * rstd * g.x; y.y = x[i].y * rstd * g.y; y.z = x[i].z * rstd * g.z; y.w = x[i].w * rstd * g.w;
        *(f32x4*)(X + (size_t)row * 1024 + col) = y;
      }
    } else {
      const int cond = cond_of_row(row);
      const float* msh = MOD + ((size_t)l * 9 + cond) * 6144 + (which ? 3072 : 0);
      const float* msc = msh + 1024;
      const float* gg = (which ? p.norm2_g : p.norm1_g) + l * 1024;
#pragma unroll
      for (int i = 0; i < 4; ++i) {
        const int col = i * 256 + lane * 4;
        const f32x4 g = *(const f32x4*)(gg + col), sh = *(const f32x4*)(msh + col), sc = *(const f32x4*)(msc + col);
        const float y0 = x[i].x * rstd * g.x * (1.f + sc.x) + sh.x, y1 = x[i].y * rstd * g.y * (1.f + sc.y) + sh.y;
        const float y2 = x[i].z * rstd * g.z * (1.f + sc.z) + sh.z, y3 = x[i].w * rstd * g.w * (1.f + sc.w) + sh.w;
        u32x2 o; o.x = pack2(y0, y1); o.y = pack2(y2, y3);
        *(u32x2*)(H + (size_t)row * 1024 + col) = o;
      }
    }
  }
}

DI int map_row(int n, int map) {
  if (map == 0) return n;
  if (map == 1) return n < 2048 ? n : (n < 2064 ? 7680 + (n - 2048) : (n < 7696 ? n - 16 : n + 112));
  if (map == 2) return 64 * (n >> 5) + (n & 31);
  return 64 * (n >> 5) + 32 + (n & 31);
}
struct TDesc { const float* src; bf16_t* dst; int src_ld, nmax, k0, n0, dst_ld, map; };
DI TDesc conv_desc(const Params& p, int l, int item) {
  constexpr int N0 = 2960, N1 = N0 + 512, N2 = N1 + 256, N3 = N2 + 704, N4 = N3 + 704, N5 = N4 + 704, N6 = N5 + 512;
  TDesc d;
  if (item < N0) {
    const int kt = item & 15, nt = item >> 4;
    d = {p.w_in + (size_t)l * 1024 * 11792, (bf16_t*)(p.ws + OFF_WTIN), 11792, 11792, kt * 64, nt * 64, 1024, 1};
  } else if (item < N1) {
    const int j = item - N0, br = j >> 7, r = j & 127, kt = r & 7, nt = r >> 3;
    d = {p.w_branch + ((size_t)(l * 4 + br) * 512) * 1024, (bf16_t*)(p.ws + OFF_WTBR) + (size_t)br * 1024 * 512, 1024, 1024, kt * 64, nt * 64, 512, 0};
  } else if (item < N2) {
    const int j = item - N1, kt = j & 15, nt = j >> 4;
    d = {p.w_out + (size_t)l * 1024 * 1024, (bf16_t*)(p.ws + OFF_WTOUT), 1024, 1024, kt * 64, nt * 64, 1024, 0};
  } else if (item < N3) {
    const int j = item - N2, kt = j & 15, nt = j >> 4;
    d = {p.w_ffn_gate + (size_t)l * 1024 * 2816, (bf16_t*)(p.ws + OFF_WTGU), 2816, 2816, kt * 64, nt * 64, 1024, 2};
  } else if (item < N4) {
    const int j = item - N3, kt = j & 15, nt = j >> 4;
    d = {p.w_ffn_up + (size_t)l * 1024 * 2816, (bf16_t*)(p.ws + OFF_WTGU), 2816, 2816, kt * 64, nt * 64, 1024, 3};
  } else if (item < N5) {
    const int j = item - N4, kt = j % 44, nt = j / 44;
    d = {p.w_ffn_down + (size_t)l * 2816 * 1024, (bf16_t*)(p.ws + OFF_WTDN), 1024, 1024, kt * 64, nt * 64, 2816, 0};
  } else if (item < N6) {
    const int j = item - N5, bh = j >> 4, r = j & 15, kt = r & 7, nt = r >> 3, b = bh >> 2, h = bh & 3;
    d = {p.cache_diff_v + ((size_t)((b * 2 + l) * 4 + h) * 512) * 128, (bf16_t*)(p.ws + OFF_VTCB) + (size_t)bh * 128 * 512, 128, 128, kt * 64, nt * 64, 512, 0};
  } else {
    const int j = item - N6, bh = j >> 3, kt = j & 7, b = bh >> 3, h = bh & 7;
    d = {p.cache_na_v + ((size_t)((b * 2 + l) * 8 + h) * 512) * 64, (bf16_t*)(p.ws + OFF_VTCD) + (size_t)bh * 64 * 512, 64, 64, kt * 64, 0, 512, 0};
  }
  return d;
}
DI void conv_load(const TDesc& d, int tid, f32x4 (&v)[4]) {
#pragma unroll
  for (int i = 0; i < 4; ++i) {
    const int k = i * 16 + (tid >> 4), n4 = (tid & 15) * 4;
    v[i] = (f32x4){0.f, 0.f, 0.f, 0.f};
    if (d.n0 + n4 < d.nmax) v[i] = *(const f32x4*)(d.src + (size_t)(d.k0 + k) * d.src_ld + d.n0 + n4);
  }
}
DI void conv_store(const TDesc& d, int tid, const f32x4 (&v)[4], float* tile) {
  __syncthreads();
#pragma unroll
  for (int i = 0; i < 4; ++i) {
    const int k = i * 16 + (tid >> 4), n4 = (tid & 15) * 4;
    tile[k * 65 + n4] = v[i].x; tile[k * 65 + n4 + 1] = v[i].y; tile[k * 65 + n4 + 2] = v[i].z; tile[k * 65 + n4 + 3] = v[i].w;
  }
  __syncthreads();
#pragma unroll
  for (int i = 0; i < 2; ++i) {
    const int n = i * 32 + (tid >> 3), k8 = (tid & 7) * 8;
    if (d.n0 + n < d.nmax) {
      float x[8];
#pragma unroll
      for (int e = 0; e < 8; ++e) x[e] = tile[(k8 + e) * 65 + n];
      *(u32x4*)(d.dst + (size_t)map_row(d.n0 + n, d.map) * d.dst_ld + d.k0 + k8) = pack8(x);
    }
  }
}
DI void phase_convert(const Params& p, int l, char* smem) {
  float* tile = (float*)smem;
  const int tid = get_tid();
  constexpr int NALL = 2960 + 512 + 256 + 704 * 3 + 512 + 512;
  if (blockIdx.x == gridDim.x - 1) {
    u32x4* z = (u32x4*)((bf16_t*)(p.ws + OFF_WTIN) + (size_t)7696 * 1024);
    const u32x4 zero = {0u, 0u, 0u, 0u};
    for (int i = tid; i < 112 * 1024 / 8; i += 256) z[i] = zero;
  }
  int item = blockIdx.x;
  asm volatile("" : "+s"(item));
  if (item >= NALL) return;
  f32x4 v[4];
  { const TDesc d = conv_desc(p, l, lrow(item)); conv_load(d, tid, v); }
  for (;;) {
    const int nitem = item + gridDim.x;
    f32x4 vn[4];
    if (nitem < NALL) { const TDesc dn = conv_desc(p, l, lrow(nitem)); conv_load(dn, tid, vn); }
    { const TDesc d = conv_desc(p, l, lrow(item)); conv_store(d, tid, v, tile); }
    if (nitem >= NALL) break;
    item = nitem;
#pragma unroll
    for (int i = 0; i < 4; ++i) v[i] = vn[i];
  }
}

DI void phase_gemm_in(const Params& p, int l, char* smem) {
  const int tid = get_tid(), lane = tid & 63, w = tid >> 6, wm = w >> 1, wn = w & 1, r = lane & 31, h = lane >> 5;
  const bf16_t* H = (const bf16_t*)(p.ws + OFF_H);
  const bf16_t* WT = (const bf16_t*)(p.ws + OFF_WTIN);
  bf16_t* P = (bf16_t*)(p.ws + OFF_P);
  bf16_t* VTB = (bf16_t*)(p.ws + OFF_VTB);
  bf16_t* VTD = (bf16_t*)(p.ws + OFF_VTD);
  int tm, tn;
  for (int it = 0; tile_map(it, 96, 61, tm, tn); ++it) {
    f32x16 acc[2][2];
    zero_acc<2, 2>(acc);
    const int m0 = tm * 128, n0 = tn * 128;
    gemm_kloop<2, 2, 3>(acc, H + (size_t)m0 * 1024, 1024, WT + (size_t)n0 * 1024, 1024, 1024, (bf16_t*)smem);
    const bool isbv = (n0 >= C_BV && n0 < C_CQ), isdv = (n0 >= C_DV && n0 < C_AA);
    if (isbv || isdv) {
      bf16_t* VT = isbv ? VTB : VTD;
      const int cbase = isbv ? C_BV : C_DV;
#pragma unroll
      for (int i = 0; i < 2; ++i)
#pragma unroll
        for (int j = 0; j < 2; ++j) {
          const int c = n0 + wn * 64 + j * 32 + r - cbase;
#pragma unroll
          for (int g = 0; g < 4; ++g) {
            const int rb = m0 + wm * 64 + i * 32 + 8 * g + 4 * h;
            size_t off;
            if (rb < NCTX) off = ((size_t)(rb >> 8) * 512 + c) * 256 + (rb & 255);
            else { const int r2 = rb - NCTX; off = (size_t)2097152 + ((size_t)(r2 >> 10) * 512 + c) * 1024 + (r2 & 1023); }
            u32x2 v; v.x = pack2(acc[i][j][4 * g], acc[i][j][4 * g + 1]); v.y = pack2(acc[i][j][4 * g + 2], acc[i][j][4 * g + 3]);
            *(u32x2*)(VT + off) = v;
          }
        }
    } else {
#pragma unroll
      for (int i = 0; i < 2; ++i)
#pragma unroll
        for (int j = 0; j < 2; ++j) {
          store_blk_bf16(P, PS, m0 + wm * 64 + i * 32, n0 + wn * 64 + j * 32 + r, acc[i][j], r, h);
        }
    }
    if (m0 < NCTX) {
      const bool isbk = (n0 >= C_BK && n0 < C_BV), isdk = (n0 >= C_DK && n0 < C_DV);
      if (isbk || isbv || isdk || isdv) {
        float* o = p.out + (isbk ? O_DK : isbv ? O_DV : isdk ? O_NK : O_NV);
        const int cbase = isbk ? C_BK : isbv ? C_BV : isdk ? C_DK : C_DV;
        const bool wide = isbk || isbv;
#pragma unroll
        for (int i = 0; i < 2; ++i)
#pragma unroll
          for (int j = 0; j < 2; ++j) {
            const int c = n0 + wn * 64 + j * 32 + r - cbase;
#pragma unroll
            for (int reg = 0; reg < 16; ++reg) {
              const int row = m0 + wm * 64 + i * 32 + crow(reg, h);
              const int b = row >> 8, t = row & 255;
              size_t off;
              if (wide) off = ((size_t)((b * 2 + l) * 4 + (c >> 7)) * 256 + t) * 128 + (c & 127);
              else off = ((size_t)((b * 2 + l) * 8 + (c >> 6)) * 256 + t) * 64 + (c & 63);
              o[off] = acc[i][j][reg];
            }
          }
      }
    }
  }
}

DI void gdn_load_raw(const bf16_t* P, int row0, int T, int tlo, int h, int dir, int dvs, int tid, u32x4 (&ra)[8], u32x4 (&rv)[5], float& raa, float& rab) {
  const int cA = tid & 31, tgA = tid >> 5;
  const int pcolA = cA < 16 ? h * 128 + cA * 8 : 512 + h * 128 + (cA - 16) * 8;
  const u32x4 z = {0u, 0u, 0u, 0u};
#pragma unroll
  for (int rr = 0; rr < 8; ++rr) {
    const int tt = tlo + tgA * 4 + rr - 2;
    ra[rr] = (tt >= 0 && tt < T) ? *(const u32x4*)(P + (size_t)(row0 + tt) * PS + pcolA) : z;
  }
  {
    const int cB = tid & 7, tB = tid >> 3;
    const int pcolB = 1024 + h * 128 + dvs * 64 + cB * 8;
#pragma unroll
    for (int j = 0; j < 5; ++j) {
      const int tt = tlo + tB + j - 2;
      rv[j] = (tt >= 0 && tt < T) ? *(const u32x4*)(P + (size_t)(row0 + tt) * PS + pcolB) : z;
    }
  }
  if (tid < 32) {
    raa = bf2f(P[(size_t)(row0 + tlo + tid) * PS + C_AA + dir * 4 + h]);
    rab = bf2f(P[(size_t)(row0 + tlo + tid) * PS + C_AB + dir * 4 + h]);
  }
}

DI void gdn_step(f32x2 (&S)[2][8], const f32x2 (&kv)[8], const f32x2 (&qv)[8], const float* scp, const float* vp, float* obp, bool wr) {
  const f32x2 sc = *(const f32x2*)scp;
  const f32x2 v = *(const f32x2*)vp;
  f32x2 pk0[2], pk1[2];
#pragma unroll
  for (int c = 0; c < 2; ++c) { pk0[c] = (f32x2){0.f, 0.f}; pk1[c] = pk0[c]; }
#pragma unroll
  for (int i = 0; i < 4; ++i)
#pragma unroll
    for (int c = 0; c < 2; ++c) { pk0[c] = S[c][2 * i] * kv[2 * i] + pk0[c]; pk1[c] = S[c][2 * i + 1] * kv[2 * i + 1] + pk1[c]; }
  const float a = sc.x;
  const f32x2 a2 = {a, a};
#pragma unroll
  for (int c = 0; c < 2; ++c) {
    const float pk = red8((pk0[c].x + pk0[c].y) + (pk1[c].x + pk1[c].y));
    const float vn = sc.y * ((c ? v.y : v.x) - a * pk);
    const f32x2 vn2 = {vn, vn};
#pragma unroll
    for (int i = 0; i < 8; ++i) { S[c][i] = S[c][i] * a2; S[c][i] = kv[i] * vn2 + S[c][i]; }
  }
  float o[2];
#pragma unroll
  for (int c = 0; c < 2; ++c) {
    f32x2 pq0 = {0.f, 0.f}, pq1 = {0.f, 0.f};
#pragma unroll
    for (int i = 0; i < 4; ++i) { pq0 = S[c][2 * i] * qv[2 * i] + pq0; pq1 = S[c][2 * i + 1] * qv[2 * i + 1] + pq1; }
    o[c] = red8((pq0.x + pq0.y) + (pq1.x + pq1.y));
  }
  if (wr) *(f32x2*)obp = (f32x2){o[0], o[1]};
}

DI void gdn_item(const Params& p, int l, bool lat, int b, int h, int dir, int dvs, char* smem) {
  if (lat) __builtin_amdgcn_s_setprio(3); else __builtin_amdgcn_s_setprio(2);
  const int tid = get_tid(), lane = tid & 63, w = tid >> 6, dkg = lane & 7, cp = lane >> 3;
  const int T = lat ? 1024 : 256;
  const int row0 = lat ? NCTX + b * 1024 : b * 256;
  float* qs = (float*)smem;
  float* ks = qs + 32 * 128;
  float* vs = ks + 32 * 128;
  float* ob = vs + 32 * 64;
  float* sc4 = ob + 32 * 64;
  float* wc = sc4 + 32 * 4;
  const bf16_t* P = (const bf16_t*)(p.ws + OFF_P);
  __syncthreads();
  for (int i = tid; i < 320 * 5; i += 256) {
    const int ci = i / 5, j = i % 5;
    const int ch = ci < 128 ? h * 128 + ci : (ci < 256 ? 512 + h * 128 + ci - 128 : 1024 + h * 128 + dvs * 64 + ci - 256);
    wc[j * 320 + ci] = p.gdn_conv_w[((size_t)l * 1536 + ch) * 5 + j];
  }
  f32x2 S[2][8];
  const int dv0 = dvs * 64 + w * 16 + cp * 2;
  if (lat) {
    const float* s0 = p.state_gdn + ((size_t)(((b * 2 + l) * 2 + dir) * 4 + h)) * 16384;
#pragma unroll
    for (int c = 0; c < 2; ++c)
#pragma unroll
      for (int i = 0; i < 8; ++i) S[c][i] = (f32x2){s0[(dkg * 16 + 2 * i) * 128 + dv0 + c], s0[(dkg * 16 + 2 * i + 1) * 128 + dv0 + c]};
  } else {
#pragma unroll
    for (int c = 0; c < 2; ++c)
#pragma unroll
      for (int i = 0; i < 8; ++i) S[c][i] = (f32x2){0.f, 0.f};
  }
  const float Acoef = -expf(p.gdn_A_log[(l * 2 + dir) * 4 + h]);
  const float dtb = p.gdn_dt_bias[(l * 2 + dir) * 4 + h];
  bf16_t* OD = (bf16_t*)(p.ws + OFF_OD) + (size_t)(0 * 2 + dir) * NTOK * 512;
  u32x4 ra[8], rv[5];
  float raa = 0.f, rab = 0.f;
  const int nb = T / 32;
  gdn_load_raw(P, row0, T, dir ? T - 32 : 0, h, dir, dvs, tid, ra, rv, raa, rab);
  __syncthreads();
  for (int bi = 0; bi < nb; ++bi) {
    const int tlo = dir ? T - 32 - bi * 32 : bi * 32;
    {
      const int cA = tid & 31, tgA = tid >> 5, ci0 = cA * 8;
      float acc[4][8];
#pragma unroll
      for (int o = 0; o < 4; ++o)
#pragma unroll
        for (int e = 0; e < 8; ++e) acc[o][e] = 0.f;
#pragma unroll
      for (int rr = 0; rr < 8; ++rr) {
        float x[8];
        unpack8(ra[rr], x);
#pragma unroll
        for (int o = 0; o < 4; ++o) {
          const int j = rr - o;
          if (j >= 0 && j <= 4) {
#pragma unroll
            for (int e = 0; e < 8; ++e) acc[o][e] += x[e] * wc[j * 320 + ci0 + e];
          }
        }
      }
#pragma unroll
      for (int o = 0; o < 4; ++o) {
        const int tok = tgA * 4 + o;
        float* dst = cA < 16 ? qs + tok * 128 + cA * 8 : ks + tok * 128 + (cA - 16) * 8;
        float y[8];
        float ss = 0.f;
#pragma unroll
        for (int e = 0; e < 8; ++e) { y[e] = siluf_(acc[o][e]); ss += y[e] * y[e]; }
        ss = red8(ss); ss += dpp_mov<0x140>(ss);
        const float sc_ = rsqrtf(ss + 1e-6f) * (cA < 16 ? 0.08838834764831845f : 1.f);
        *(f32x4*)dst = (f32x4){y[0] * sc_, y[1] * sc_, y[2] * sc_, y[3] * sc_};
        *(f32x4*)(dst + 4) = (f32x4){y[4] * sc_, y[5] * sc_, y[6] * sc_, y[7] * sc_};
      }
    }
    {
      const int cB = tid & 7, tB = tid >> 3, ci0 = 256 + cB * 8;
      float acc[8];
#pragma unroll
      for (int e = 0; e < 8; ++e) acc[e] = 0.f;
#pragma unroll
      for (int j = 0; j < 5; ++j) {
        float x[8];
        unpack8(rv[j], x);
#pragma unroll
        for (int e = 0; e < 8; ++e) acc[e] += x[e] * wc[j * 320 + ci0 + e];
      }
      float* dst = vs + tB * 64 + cB * 8;
      f32x4 y0 = {siluf_(acc[0]), siluf_(acc[1]), siluf_(acc[2]), siluf_(acc[3])};
      f32x4 y1 = {siluf_(acc[4]), siluf_(acc[5]), siluf_(acc[6]), siluf_(acc[7])};
      *(f32x4*)dst = y0; *(f32x4*)(dst + 4) = y1;
    }
    if (tid < 32) {
      const float x = raa + dtb;
      const float sp = x > 20.f ? x : log1pf(expf(x));
      sc4[tid * 4 + 0] = expf(Acoef * sp);
      sc4[tid * 4 + 1] = sigmoidf_(rab);
    }
    __syncthreads();
    if (bi + 1 < nb) gdn_load_raw(P, row0, T, dir ? T - 64 - bi * 32 : (bi + 1) * 32, h, dir, dvs, tid, ra, rv, raa, rab);
    {
      f32x2 kvA[8], kvB[8], qvA[8], qvB[8];
      int tok = dir ? 31 : 0;
      const int dt = dir ? -1 : 1;
      const int vo = w * 16 + cp * 2;
      ld16(ks + tok * 128 + dkg * 16, kvA); ld16(qs + tok * 128 + dkg * 16, qvA);
#pragma unroll 1
      for (int s = 0; s < 32; s += 2) {
        {
          const int tn = tok + dt;
          ld16(ks + tn * 128 + dkg * 16, kvB); ld16(qs + tn * 128 + dkg * 16, qvB);
          gdn_step(S, kvA, qvA, sc4 + tok * 4, vs + tok * 64 + vo, ob + tok * 64 + vo, dkg == 0);
          tok = tn;
        }
        {
          const int tn = tok + dt;
          if (s + 2 < 32) { ld16(ks + tn * 128 + dkg * 16, kvA); ld16(qs + tn * 128 + dkg * 16, qvA); }
          gdn_step(S, kvB, qvB, sc4 + tok * 4, vs + tok * 64 + vo, ob + tok * 64 + vo, dkg == 0);
          tok = tn;
        }
      }
    }
    __syncthreads();
    {
      const int tok = tid >> 3, c8 = (tid & 7) * 8;
      *(u32x4*)(OD + (size_t)(row0 + tlo + tok) * 512 + h * 128 + dvs * 64 + c8) = pack8(ob + tok * 64 + c8);
    }
  }
  if (!lat) {
    float* so = p.out + O_SGDN + ((size_t)(((b * 2 + l) * 2 + dir) * 4 + h)) * 16384;
#pragma unroll
    for (int c = 0; c < 2; ++c)
#pragma unroll
      for (int i = 0; i < 8; ++i) { so[(dkg * 16 + 2 * i) * 128 + dv0 + c] = S[c][i].x; so[(dkg * 16 + 2 * i + 1) * 128 + dv0 + c] = S[c][i].y; }
  }
  __builtin_amdgcn_s_setprio(0);
}

DI void hgrn_load_raw(const bf16_t* P, int row0, int tlo, int h, int dir, int dvs, int tid, u32x4 (&rh)[5]) {
#pragma unroll
  for (int j = 0; j < 5; ++j) {
    const int u = tid + j * 256;
    if (u < 512) { const int tok = u >> 4, ch = u & 15; rh[j] = *(const u32x4*)(P + (size_t)(row0 + tlo + tok) * PS + C_CF + dir * 512 + h * 128 + ch * 8); }
    else if (u < 1024) { const int uu = u - 512, tok = uu >> 4, ch = uu & 15; rh[j] = *(const u32x4*)(P + (size_t)(row0 + tlo + tok) * PS + C_CQ + h * 128 + ch * 8); }
    else { const int uu = u - 1024, tok = uu >> 3, ch = uu & 7; rh[j] = *(const u32x4*)(P + (size_t)(row0 + tlo + tok) * PS + C_CI + h * 128 + dvs * 64 + ch * 8); }
  }
}
DI void hgrn_step(f32x2 (&D)[2][8], const f32x2 (&fv)[8], const f32x2 (&qv)[8], const f32x2 vcur, const f32x2 vnext, const float qsum, float* obp, bool wr) {
  float o[2];
#pragma unroll
  for (int c = 0; c < 2; ++c) {
    const float dvc = c ? vcur.y - vnext.y : vcur.x - vnext.x;
    const f32x2 dv2 = {dvc, dvc};
    f32x2 po0 = {0.f, 0.f}, po1 = {0.f, 0.f};
#pragma unroll
    for (int i = 0; i < 4; ++i) {
      D[c][2 * i] = fv[2 * i] * D[c][2 * i] + dv2; po0 = D[c][2 * i] * qv[2 * i] + po0;
      D[c][2 * i + 1] = fv[2 * i + 1] * D[c][2 * i + 1] + dv2; po1 = D[c][2 * i + 1] * qv[2 * i + 1] + po1;
    }
    o[c] = red8((po0.x + po0.y) + (po1.x + po1.y)) + (c ? vnext.y : vnext.x) * qsum;
  }
  if (wr) *(f32x2*)obp = (f32x2){o[0], o[1]};
}
DI void hgrn_item(const Params& p, int l, bool lat, int b, int h, int dir, int dvs, char* smem) {
  if (lat) __builtin_amdgcn_s_setprio(3); else __builtin_amdgcn_s_setprio(2);
  const int tid = get_tid(), lane = tid & 63, w = tid >> 6, dkg = lane & 7, cp = lane >> 3;
  const int T = lat ? 1024 : 256;
  const int row0 = lat ? NCTX + b * 1024 : b * 256;
  float* fs = (float*)smem;
  float* qs = fs + 32 * 128;
  float* vs = qs + 32 * 128;
  float* ob = vs + 32 * 64;
  float* qsum = ob + 32 * 64;
  const bf16_t* P = (const bf16_t*)(p.ws + OFF_P);
  const float* LB = (const float*)(p.ws + OFF_LB) + (l * 2 + dir) * 512 + h * 128;
  f32x2 S[2][8];
  const int dv0 = dvs * 64 + w * 16 + cp * 2;
  if (lat) {
    const float* s0 = p.state_hgrn + ((size_t)(((b * 2 + l) * 2 + dir) * 4 + h)) * 16384;
#pragma unroll
    for (int c = 0; c < 2; ++c)
#pragma unroll
      for (int i = 0; i < 8; ++i) S[c][i] = (f32x2){s0[(dkg * 16 + 2 * i) * 128 + dv0 + c], s0[(dkg * 16 + 2 * i + 1) * 128 + dv0 + c]};
  } else {
#pragma unroll
    for (int c = 0; c < 2; ++c)
#pragma unroll
      for (int i = 0; i < 8; ++i) S[c][i] = (f32x2){0.f, 0.f};
  }
  bf16_t* OD = (bf16_t*)(p.ws + OFF_OD) + (size_t)(1 * 2 + dir) * NTOK * 512;
  u32x4 rh[5];
  const int nb = T / 32;
  hgrn_load_raw(P, row0, dir ? T - 32 : 0, h, dir, dvs, tid, rh);
  for (int bi = 0; bi < nb; ++bi) {
    const int tlo = dir ? T - 32 - bi * 32 : bi * 32;
    __syncthreads();
#pragma unroll
    for (int j = 0; j < 5; ++j) {
      const int u = tid + j * 256;
      float x[8];
      unpack8(rh[j], x);
      if (u < 512) {
        const int tok = u >> 4, ch = u & 15;
        float y[8];
#pragma unroll
        for (int e = 0; e < 8; ++e) { const float lb = LB[ch * 8 + e]; y[e] = fmaxf(lb + (1.f - lb) * sigmoidf_(x[e]), 1e-30f); }
        *(f32x4*)(fs + tok * 128 + ch * 8) = (f32x4){y[0], y[1], y[2], y[3]}; *(f32x4*)(fs + tok * 128 + ch * 8 + 4) = (f32x4){y[4], y[5], y[6], y[7]};
      } else if (u < 1024) {
        const int uu = u - 512, tok = uu >> 4, ch = uu & 15;
        float y[8];
#pragma unroll
        for (int e = 0; e < 8; ++e) y[e] = siluf_(x[e]);
        *(f32x4*)(qs + tok * 128 + ch * 8) = (f32x4){y[0], y[1], y[2], y[3]};
        *(f32x4*)(qs + tok * 128 + ch * 8 + 4) = (f32x4){y[4], y[5], y[6], y[7]};
        float ps = ((y[0] + y[1]) + (y[2] + y[3])) + ((y[4] + y[5]) + (y[6] + y[7]));
        ps = red8(ps); ps += dpp_mov<0x140>(ps);
        if (ch == 0) qsum[tok] = ps;
      } else {
        const int uu = u - 1024, tok = uu >> 3, ch = uu & 7;
        *(f32x4*)(vs + tok * 64 + ch * 8) = (f32x4){x[0], x[1], x[2], x[3]}; *(f32x4*)(vs + tok * 64 + ch * 8 + 4) = (f32x4){x[4], x[5], x[6], x[7]};
      }
    }
    __syncthreads();
    if (bi + 1 < nb) hgrn_load_raw(P, row0, dir ? T - 64 - bi * 32 : (bi + 1) * 32, h, dir, dvs, tid, rh);
    {
      f32x2 fvA[8], qvA[8], fvB[8], qvB[8];
      f32x2 vA, vB;
      float qsA, qsB;
      int tok = dir ? 31 : 0;
      const int dt = dir ? -1 : 1;
      const int vo = w * 16 + cp * 2;
      ld16(fs + tok * 128 + dkg * 16, fvA); ld16(qs + tok * 128 + dkg * 16, qvA); vA = *(const f32x2*)(vs + tok * 64 + vo); qsA = qsum[tok];
#pragma unroll
      for (int c = 0; c < 2; ++c) {
        const float vc = c ? vA.y : vA.x;
        const f32x2 v2 = {vc, vc};
#pragma unroll
        for (int i = 0; i < 8; ++i) S[c][i] = S[c][i] - v2;
      }
#pragma unroll 1
      for (int s = 0; s < 32; s += 2) {
        {
          const int tn = tok + dt;
          ld16(fs + tn * 128 + dkg * 16, fvB); ld16(qs + tn * 128 + dkg * 16, qvB); vB = *(const f32x2*)(vs + tn * 64 + vo); qsB = qsum[tn];
          hgrn_step(S, fvA, qvA, vA, vB, qsA, ob + tok * 64 + vo, dkg == 0);
          tok = tn;
        }
        {
          const int tn = tok + dt;
          vA = (f32x2){0.f, 0.f};
          if (s + 2 < 32) { ld16(fs + tn * 128 + dkg * 16, fvA); ld16(qs + tn * 128 + dkg * 16, qvA); vA = *(const f32x2*)(vs + tn * 64 + vo); qsA = qsum[tn]; }
          hgrn_step(S, fvB, qvB, vB, vA, qsB, ob + tok * 64 + vo, dkg == 0);
          tok = tn;
        }
      }
    }
    __syncthreads();
    {
      const int tok = tid >> 3, c8 = (tid & 7) * 8;
      *(u32x4*)(OD + (size_t)(row0 + tlo + tok) * 512 + h * 128 + dvs * 64 + c8) = pack8(ob + tok * 64 + c8);
    }
  }
  if (!lat) {
    float* so = p.out + O_SHGRN + ((size_t)(((b * 2 + l) * 2 + dir) * 4 + h)) * 16384;
#pragma unroll
    for (int c = 0; c < 2; ++c)
#pragma unroll
      for (int i = 0; i < 8; ++i) { so[(dkg * 16 + 2 * i) * 128 + dv0 + c] = S[c][i].x; so[(dkg * 16 + 2 * i + 1) * 128 + dv0 + c] = S[c][i].y; }
  }
  __builtin_amdgcn_s_setprio(0);
}

struct AttnDesc {
  int ntiles, nctx, newkey0, rope;
  const float* ck; int ckstride;
  const bf16_t* vtc;
  const bf16_t* pk;
  const bf16_t* vtn; int vtn_stride;
};

template <int DV, bool NA>
DI void attn_pass(const Params& p, const AttnDesc& d, const bf16x8 (&qf)[4], f32x16 (&oacc)[DV / 32], float& lsum_out, char* smem, int qrow, int qcol) {
  const int tid = get_tid(), lane = tid & 63, r = lane & 31, h = lane >> 5;
  bf16_t* Ks = (bf16_t*)smem;
  bf16_t* Vs = Ks + 64 * 72;
  const float* rp = (const float*)(smem + 27648);
  const float* rc = (const float*)(p.ws + OFF_ROPE);
  const float* rs = rc + 1024 * 32;
  float m = -1e30f, lsum = 0.f;
#pragma unroll
  for (int i = 0; i < DV / 32; ++i)
#pragma unroll
    for (int q = 0; q < 16; ++q) oacc[i][q] = 0.f;
  const int myr0 = NA ? min(max(qrow - 4, 0), 8) : 0;
  const int myc0 = NA ? min(max(qcol - 8, 0), 48) : 0;
  for (int ti = 0; ti < d.ntiles; ++ti) {
    __syncthreads();
    {
      const int key = tid >> 2, c = tid & 3;
      float x1[8], x2[8];
      if (ti < d.nctx) {
        const float* src = d.ck + (size_t)(ti * 64 + key) * d.ckstride;
        const f32x4 a0 = *(const f32x4*)(src + 8 * c), a1 = *(const f32x4*)(src + 8 * c + 4);
        const f32x4 b0 = *(const f32x4*)(src + 32 + 8 * c), b1 = *(const f32x4*)(src + 32 + 8 * c + 4);
        x1[0] = a0.x; x1[1] = a0.y; x1[2] = a0.z; x1[3] = a0.w; x1[4] = a1.x; x1[5] = a1.y; x1[6] = a1.z; x1[7] = a1.w;
        x2[0] = b0.x; x2[1] = b0.y; x2[2] = b0.z; x2[3] = b0.w; x2[4] = b1.x; x2[5] = b1.y; x2[6] = b1.z; x2[7] = b1.w;
      } else {
        const int kk = d.newkey0 + (ti - d.nctx) * 64 + key;
        const bf16_t* src = d.pk + (size_t)kk * PS;
        const u32x4 a = *(const u32x4*)(src + 8 * c), bb = *(const u32x4*)(src + 32 + 8 * c);
        unpack8(a, x1); unpack8(bb, x2);
        if (d.rope) {
#pragma unroll
          for (int e = 0; e < 8; ++e) {
            const float cs = rc[kk * 32 + 8 * c + e], sn = rs[kk * 32 + 8 * c + e];
            const float y1 = x1[e] * cs - x2[e] * sn, y2 = x2[e] * cs + x1[e] * sn;
            x1[e] = y1; x2[e] = y2;
          }
        }
      }
      *(u32x4*)(Ks + key * 72 + 8 * c) = pack8(x1);
      *(u32x4*)(Ks + key * 72 + 32 + 8 * c) = pack8(x2);
    }
#pragma unroll
    for (int u = tid; u < DV * 8; u += 256) {
      const int dv = u >> 3, ch = u & 7;
      const bf16_t* src = ti < d.nctx ? d.vtc + (size_t)dv * 512 + ti * 64 + ch * 8
                                      : d.vtn + (size_t)dv * d.vtn_stride + d.newkey0 + (ti - d.nctx) * 64 + ch * 8;
      *(u32x4*)(Vs + dv * 72 + ch * 8) = *(const u32x4*)src;
    }
    __syncthreads();
    f32x16 st[2];
#pragma unroll
    for (int kb = 0; kb < 2; ++kb) {
#pragma unroll
      for (int q = 0; q < 16; ++q) st[kb][q] = 0.f;
#pragma unroll
      for (int ks = 0; ks < 4; ++ks) {
        const bf16x8 a = *(const bf16x8*)(Ks + (kb * 32 + r) * 72 + ks * 16 + h * 8);
        st[kb] = MFMA32(a, qf[ks], st[kb]);
      }
    }
    if (NA && ti >= d.nctx) {
      const int kr = d.newkey0 / 64 + (ti - d.nctx);
      const bool rowok = (kr >= myr0) && (kr < myr0 + 8);
      const int dr = min(max(kr - qrow + 7, 0), 14);
#pragma unroll
      for (int kb = 0; kb < 2; ++kb)
#pragma unroll
        for (int reg = 0; reg < 16; ++reg) {
          const int kc = kb * 32 + crow(reg, h);
          const bool ok = rowok && (kc >= myc0) && (kc < myc0 + 16);
          const int dc = min(max(kc - qcol + 15, 0), 30);
          st[kb][reg] = ok ? st[kb][reg] + rp[dr * 31 + dc] : -1e30f;
        }
    }
    float mx = -1e30f;
#pragma unroll
    for (int kb = 0; kb < 2; ++kb)
#pragma unroll
      for (int reg = 0; reg < 16; ++reg) mx = fmaxf(mx, st[kb][reg]);
    mx = fmaxf(mx, __shfl_xor(mx, 32));
    const float mnew = fmaxf(m, mx);
    const float alpha = __builtin_amdgcn_exp2f(m - mnew);
    m = mnew;
    float psum = 0.f;
#pragma unroll
    for (int kb = 0; kb < 2; ++kb)
#pragma unroll
      for (int reg = 0; reg < 16; ++reg) { const float e = __builtin_amdgcn_exp2f(st[kb][reg] - mnew); st[kb][reg] = e; psum += e; }
    psum += __shfl_xor(psum, 32);
    lsum = lsum * alpha + psum;
    if (__any(alpha != 1.f)) {
#pragma unroll
      for (int i = 0; i < DV / 32; ++i)
#pragma unroll
        for (int q = 0; q < 16; ++q) oacc[i][q] *= alpha;
    }
#pragma unroll
    for (int kb = 0; kb < 2; ++kb)
#pragma unroll
      for (int s = 0; s < 2; ++s) {
        u32x4 pu;
        pu.x = pack2(st[kb][8 * s + 0], st[kb][8 * s + 1]); pu.y = pack2(st[kb][8 * s + 2], st[kb][8 * s + 3]);
        pu.z = pack2(st[kb][8 * s + 4], st[kb][8 * s + 5]); pu.w = pack2(st[kb][8 * s + 6], st[kb][8 * s + 7]);
        const bf16x8 pf = __builtin_bit_cast(bf16x8, pu);
#pragma unroll
        for (int dvb = 0; dvb < DV / 32; ++dvb) {
          const bf16_t* vrow = Vs + (dvb * 32 + r) * 72 + kb * 32 + 16 * s + 4 * h;
          const s16x4 lo = *(const s16x4*)(vrow), hi = *(const s16x4*)(vrow + 8);
          const bf16x8 a2 = __builtin_shufflevector(lo, hi, 0, 1, 2, 3, 4, 5, 6, 7);
          oacc[dvb] = MFMA32(a2, pf, oacc[dvb]);
        }
      }
  }
  lsum_out = lsum;
}

DI void diff_item(const Params& p, int l, bool lat, int b, int h, int qt, char* smem, int dry) {
  const int tid = get_tid(), lane = tid & 63, w = tid >> 6, r = lane & 31, hh = lane >> 5;
  bf16_t* P = (bf16_t*)(p.ws + OFF_P);
  const int T = lat ? 1024 : 256, row0 = lat ? NCTX + b * 1024 : b * 256;
  const int pos = qt * 128 + w * 32 + r;
  const size_t rowq = (size_t)(row0 + pos);
  const float* rc = (const float*)(p.ws + OFF_ROPE);
  const float* rs = rc + 1024 * 32;
  unsigned* stash = (unsigned*)(smem + 29696);
  f32x16 res[4];
#pragma unroll 1
  for (int mm = 0; mm < 2; ++mm) {
    float q[4][8];
#pragma unroll
    for (int ks = 0; ks < 4; ++ks) { const u32x4 v = *(const u32x4*)(P + rowq * PS + C_BQ + h * 128 + mm * 64 + ks * 16 + hh * 8); unpack8(v, q[ks]); }
    if (lat) {
#pragma unroll
      for (int ks = 0; ks < 2; ++ks)
#pragma unroll
        for (int e = 0; e < 8; ++e) {
          const int pi = ks * 16 + hh * 8 + e;
          const float cs = rc[pos * 32 + pi], sn = rs[pos * 32 + pi];
          const float x1 = q[ks][e], x2 = q[ks + 2][e];
          q[ks][e] = x1 * cs - x2 * sn; q[ks + 2][e] = x2 * cs + x1 * sn;
        }
    }
    bf16x8 qf[4];
#pragma unroll
    for (int ks = 0; ks < 4; ++ks) {
#pragma unroll
      for (int e = 0; e < 8; ++e) q[ks][e] *= 0.18033688011112042f;
      qf[ks] = __builtin_bit_cast(bf16x8, pack8(q[ks]));
    }
    AttnDesc d;
    if (lat) {
      d.ntiles = 24; d.nctx = 8; d.newkey0 = 0; d.rope = 1;
      d.ck = p.cache_diff_k + ((size_t)((b * 2 + l) * 4 + h) * 512) * 128 + mm * 64; d.ckstride = 128;
      d.vtc = (const bf16_t*)(p.ws + OFF_VTCB) + (size_t)(b * 4 + h) * 128 * 512;
      d.pk = P + (size_t)row0 * PS + C_BK + h * 128 + mm * 64;
      d.vtn = (const bf16_t*)(p.ws + OFF_VTB) + (size_t)2097152 + ((size_t)b * 512 + h * 128) * 1024; d.vtn_stride = 1024;
    } else {
      d.ntiles = 4; d.nctx = 0; d.newkey0 = 0; d.rope = 0;
      d.ck = nullptr; d.ckstride = 0; d.vtc = nullptr;
      d.pk = P + (size_t)row0 * PS + C_BK + h * 128 + mm * 64;
      d.vtn = (const bf16_t*)(p.ws + OFF_VTB) + ((size_t)b * 512 + h * 128) * 256; d.vtn_stride = 256;
    }
    f32x16 oacc[4];
    float lsum;
    attn_pass<128, false>(p, d, qf, oacc, lsum, smem, 0, 0);
    const float coef = (mm == 0 ? 1.f : -((const float*)(p.ws + OFF_CTR))[16 + l]) / lsum;
    if (mm == 0) {
#pragma unroll
      for (int i = 0; i < 4; ++i)
#pragma unroll
        for (int q2 = 0; q2 < 8; ++q2) stash[(i * 8 + q2) * 256 + tid] = pack2(coef * oacc[i][2 * q2], coef * oacc[i][2 * q2 + 1]);
    } else {
#pragma unroll
      for (int i = 0; i < 4; ++i)
#pragma unroll
        for (int q2 = 0; q2 < 8; ++q2) {
          const unsigned u = stash[(i * 8 + q2) * 256 + tid];
          res[i][2 * q2] = lo2f(u) + coef * oacc[i][2 * q2];
          res[i][2 * q2 + 1] = hi2f(u) + coef * oacc[i][2 * q2 + 1];
        }
    }
  }
  float ss = 0.f;
#pragma unroll
  for (int i = 0; i < 4; ++i)
#pragma unroll
    for (int q2 = 0; q2 < 16; ++q2) ss += res[i][q2] * res[i][q2];
  ss += __shfl_xor(ss, 32);
  const float rstd = rsqrtf(ss * (1.f / 128.f) + 1e-6f) * ((const float*)(p.ws + OFF_CTR))[18 + l];
  const float* g = p.diff_norm_g + l * 128;
#pragma unroll
  for (int i = 0; i < 4; ++i)
#pragma unroll
    for (int gq = 0; gq < 4; ++gq) {
      const int dv = i * 32 + 8 * gq + 4 * hh;
      u32x2 v;
      v.x = pack2(res[i][4 * gq] * rstd * g[dv], res[i][4 * gq + 1] * rstd * g[dv + 1]);
      v.y = pack2(res[i][4 * gq + 2] * rstd * g[dv + 2], res[i][4 * gq + 3] * rstd * g[dv + 3]);
      if (!dry) *(u32x2*)(P + rowq * PS + C_BQ + h * 128 + dv) = v;
    }
}

DI void na_item(const Params& p, int l, bool lat, int b, int h, int idx, char* smem, int dry) {
  const int tid = get_tid(), lane = tid & 63, w = tid >> 6, r = lane & 31, hh = lane >> 5;
  bf16_t* P = (bf16_t*)(p.ws + OFF_P);
  const int row0 = lat ? NCTX + b * 1024 : b * 256;
  int qrow = 0, qcol = 0, pos;
  if (lat) { qrow = idx * 2 + (w >> 1); qcol = (w & 1) * 32 + r; pos = qrow * 64 + qcol; }
  else pos = idx * 128 + w * 32 + r;
  const size_t rowq = (size_t)(row0 + pos);
  float q[4][8];
  bf16x8 qf[4];
#pragma unroll
  for (int ks = 0; ks < 4; ++ks) {
    const u32x4 v = *(const u32x4*)(P + rowq * PS + C_DQ + h * 64 + ks * 16 + hh * 8);
    unpack8(v, q[ks]);
#pragma unroll
    for (int e = 0; e < 8; ++e) q[ks][e] *= 0.18033688011112042f;
    qf[ks] = __builtin_bit_cast(bf16x8, pack8(q[ks]));
  }
  AttnDesc d;
  f32x16 oacc[2];
  float lsum;
  if (lat) {
    const int rbase = idx * 2;
    const int rlo = min(max(rbase - 4, 0), 8), rhi = min(max(rbase + 1 - 4, 0), 8) + 7;
    __syncthreads();
    float* rp = (float*)(smem + 27648);
    for (int i = tid; i < 465; i += 256) rp[i] = p.na_rpb[((size_t)l * 8 + h) * 465 + i] * 1.4426950408889634f;
    d.ntiles = 8 + (rhi - rlo + 1); d.nctx = 8; d.newkey0 = rlo * 64; d.rope = 0;
    d.ck = p.cache_na_k + ((size_t)((b * 2 + l) * 8 + h) * 512) * 64; d.ckstride = 64;
    d.vtc = (const bf16_t*)(p.ws + OFF_VTCD) + (size_t)(b * 8 + h) * 64 * 512;
    d.pk = P + (size_t)row0 * PS + C_DK + h * 64;
    d.vtn = (const bf16_t*)(p.ws + OFF_VTD) + (size_t)2097152 + ((size_t)b * 512 + h * 64) * 1024; d.vtn_stride = 1024;
    attn_pass<64, true>(p, d, qf, oacc, lsum, smem, qrow, qcol);
  } else {
    d.ntiles = 4; d.nctx = 0; d.newkey0 = 0; d.rope = 0;
    d.ck = nullptr; d.ckstride = 0; d.vtc = nullptr;
    d.pk = P + (size_t)row0 * PS + C_DK + h * 64;
    d.vtn = (const bf16_t*)(p.ws + OFF_VTD) + ((size_t)b * 512 + h * 64) * 256; d.vtn_stride = 256;
    attn_pass<64, false>(p, d, qf, oacc, lsum, smem, 0, 0);
  }
  const float inv = 1.f / lsum;
#pragma unroll
  for (int i = 0; i < 2; ++i)
#pragma unroll
    for (int gq = 0; gq < 4; ++gq) {
      const int dv = i * 32 + 8 * gq + 4 * hh;
      u32x2 v;
      v.x = pack2(oacc[i][4 * gq] * inv, oacc[i][4 * gq + 1] * inv);
      v.y = pack2(oacc[i][4 * gq + 2] * inv, oacc[i][4 * gq + 3] * inv);
      if (!dry) *(u32x2*)(P + rowq * PS + C_DQ + h * 64 + dv) = v;
    }
}

DI void phase_mixers(const Params& p, int l, char* smem, int sel, int dry, int cidx) {
  __shared__ int s_item;
  __shared__ int s_q[4];
  if (threadIdx.x == 0) {
    const unsigned hw = (unsigned)__builtin_amdgcn_s_getreg((31 << 11) | 4);
    const unsigned key = ((xb_xcc_id() & 7u) << 8) | (((hw >> 13) & 7u) << 5) | (((hw >> 12) & 1u) << 4) | ((hw >> 8) & 15u);
    s_q[0] = (int)(atomicAdd((unsigned*)(p.ws + OFF_CUCTR) + cidx * 2048 + key, 1u) & 1u);
    s_q[1] = !(sel & 1); s_q[2] = !(sel & 2);
  }
  for (;;) {
    __syncthreads();
    if (threadIdx.x == 0) {
      unsigned* qc = (unsigned*)(p.ws + OFF_CTR) + 32 + cidx * 2;
      const int pref = s_q[0];
      int it = -1;
      for (int tr = 0; tr < 2 && it < 0; ++tr) {
        const int q = tr == 0 ? pref : 1 - pref;
        if (s_q[1 + q]) continue;
        const int v = (int)atomicAdd(qc + q, 1u);
        if (v < (q == 0 ? 768 : 1152)) it = q * 1024 + v;
        else s_q[1 + q] = 1;
      }
      s_item = it;
    }
    __syncthreads();
    const int item = s_item;
    if (item < 0) break;
    if (item < 128) { const int i = item; gdn_item(p, l, true, i >> 4, (i >> 2) & 3, (i >> 1) & 1, i & 1, smem); }
    else if (item < 256) { const int i = item - 128; hgrn_item(p, l, true, i >> 4, (i >> 2) & 3, (i >> 1) & 1, i & 1, smem); }
    else if (item < 512) { const int i = item - 256; gdn_item(p, l, false, i >> 4, (i >> 2) & 3, (i >> 1) & 1, i & 1, smem); }
    else if (item < 768) { const int i = item - 512; hgrn_item(p, l, false, i >> 4, (i >> 2) & 3, (i >> 1) & 1, i & 1, smem); }
    else if (item < 1024 + 256) { const int i = item - 1024; diff_item(p, l, true, i >> 5, (i >> 3) & 3, i & 7, smem, dry); }
    else if (item < 1024 + 768) { const int i = item - 1024 - 256; na_item(p, l, true, i >> 6, (i >> 3) & 7, i & 7, smem, dry); }
    else if (item < 1024 + 896) { const int i = item - 1024 - 768; diff_item(p, l, false, i >> 3, (i >> 1) & 3, i & 1, smem, dry); }
    else { const int i = item - 1024 - 896; na_item(p, l, false, i >> 4, (i >> 1) & 7, i & 1, smem, dry); }
  }
}

DI void phase_combine(const Params& p, int l, int dry) {
  const int tid = get_tid(), lane = tid & 63, w = tid >> 6;
  bf16_t* P = (bf16_t*)(p.ws + OFF_P);
  const bf16_t* OD = (const bf16_t*)(p.ws + OFF_OD);
  for (int it = blockIdx.x; it < NTOK * 2; it += gridDim.x) {
    const int wi = it * 4 + w;
    const int token = wi >> 3, mh = wi & 7, mixer = mh >> 2, h = mh & 3;
    const size_t o0 = ((size_t)(mixer * 2 + 0) * NTOK + token) * 512 + h * 128 + lane * 2;
    const size_t o1 = ((size_t)(mixer * 2 + 1) * NTOK + token) * 512 + h * 128 + lane * 2;
    const unsigned a = *(const unsigned*)(OD + o0), bq = *(const unsigned*)(OD + o1);
    const float v0 = lo2f(a) + lo2f(bq), v1 = hi2f(a) + hi2f(bq);
    float ss = v0 * v0 + v1 * v1;
    ss = wave_sum(ss);
    const float rstd = rsqrtf(ss * (1.f / 128.f) + 1e-6f);
    const float* g = (mixer ? p.hgrn_norm_g : p.gdn_norm_g) + l * 128 + lane * 2;
    bf16_t* zp = P + (size_t)token * PS + (mixer ? C_CG : C_AZ) + h * 128 + lane * 2;
    const unsigned z = *(const unsigned*)zp;
    const float y0 = v0 * rstd * g[0] * siluf_(lo2f(z)), y1 = v1 * rstd * g[1] * siluf_(hi2f(z));
    if (dry) zp = (bf16_t*)(p.ws + OFF_WTIN) + ((size_t)(wi & 0xfffff) * 8 + lane * 2 % 8);
    *(unsigned*)zp = pack2(y0, y1);
  }
}

template <int NJ>
DI void merge_tile(const Params& p, char* smem, int m0, int n0) {
  const int tid = get_tid(), lane = tid & 63, w = tid >> 6, wm = w >> 1, wn = w & 1, r = lane & 31, h = lane >> 5;
  const bf16_t* H = (const bf16_t*)(p.ws + OFF_H);
  const bf16_t* P = (const bf16_t*)(p.ws + OFF_P);
  const bf16_t* WTMG = (const bf16_t*)(p.ws + OFF_WTIN) + (size_t)7808 * 1024;
  const bf16_t* WTBR = (const bf16_t*)(p.ws + OFF_WTBR);
  bf16_t* M = (bf16_t*)(p.ws + OFF_M);
  f32x16 macc[2][NJ];
  zero_acc<2, NJ>(macc);
#pragma unroll 1
  for (int n = 0; n < 4; ++n) {
    unsigned gt[2][NJ][8];
    {
      f32x16 a1[2][NJ];
      zero_acc<2, NJ>(a1);
      gemm_kloop<2, NJ, 3>(a1, H + (size_t)m0 * 1024, 1024, WTMG + ((size_t)n * 1024 + n0) * 1024, 1024, 1024, (bf16_t*)smem);
#pragma unroll
      for (int i = 0; i < 2; ++i)
#pragma unroll
        for (int j = 0; j < NJ; ++j)
#pragma unroll
          for (int q = 0; q < 8; ++q) gt[i][j][q] = pack2(sigmoidf_(a1[i][j][2 * q]), sigmoidf_(a1[i][j][2 * q + 1]));
    }
    const int bcol = n == 0 ? C_AZ : (n == 1 ? C_BQ : (n == 2 ? C_CG : C_DQ));
    {
      f32x16 a2[2][NJ];
      zero_acc<2, NJ>(a2);
      gemm_kloop<2, NJ, 3>(a2, P + (size_t)m0 * PS + bcol, PS, WTBR + ((size_t)n * 1024 + n0) * 512, 512, 512, (bf16_t*)smem);
#pragma unroll
      for (int i = 0; i < 2; ++i)
#pragma unroll
        for (int j = 0; j < NJ; ++j)
#pragma unroll
          for (int q = 0; q < 8; ++q) {
            macc[i][j][2 * q] += lo2f(gt[i][j][q]) * a2[i][j][2 * q];
            macc[i][j][2 * q + 1] += hi2f(gt[i][j][q]) * a2[i][j][2 * q + 1];
          }
    }
  }
#pragma unroll
  for (int i = 0; i < 2; ++i)
#pragma unroll
    for (int j = 0; j < NJ; ++j) {
      store_blk_bf16(M, 1024, m0 + wm * 64 + i * 32, n0 + wn * 32 * NJ + j * 32 + r, macc[i][j], r, h);
    }
}
DI void phase_merge(const Params& p, int l, char* smem) {
  const int xcd = blockIdx.x & 7, local = blockIdx.x >> 3, nloc = gridDim.x >> 3;
  if (nloc == 64) {
    { const int w = local; merge_tile<2>(p, smem, (xcd * 12 + w % 12) * 128, (w / 12) * 128); }
    { const int w = 64 + (local >> 1); merge_tile<1>(p, smem, (xcd * 12 + w % 12) * 128, (w / 12) * 128 + (local & 1) * 64); }
  } else {
    int tm, tn;
    for (int it = 0; tile_map(it, 96, 16, tm, tn); ++it) merge_tile<1>(p, smem, tm * 128, tn * 64);
  }
}

template <int NJ>
DI void resid_tile(const Params& p, int l, int which, char* smem, int m0, int n0) {
  const int tid = get_tid(), lane = tid & 63, w = tid >> 6, wm = w >> 1, wn = w & 1, r = lane & 31, h = lane >> 5;
  const bf16_t* A = (const bf16_t*)(p.ws + (which ? OFF_G : OFF_M));
  const int K = which ? 2816 : 1024;
  const bf16_t* WT = (const bf16_t*)(p.ws + (which ? OFF_WTDN : OFF_WTOUT));
  const float* MOD = (const float*)(p.ws + OFF_MOD);
  float* X = p.out;
  const bool first = (l == 0 && which == 0);
  f32x16 acc[2][NJ];
  zero_acc<2, NJ>(acc);
  gemm_kloop<2, NJ, 3>(acc, A + (size_t)m0 * K, K, WT + (size_t)n0 * K, K, K, (bf16_t*)smem);
  const int cond = cond_of_row(m0);
#pragma unroll
  for (int j = 0; j < NJ; ++j) {
    const int col = n0 + wn * 32 * NJ + j * 32 + r;
    const float gate = MOD[((size_t)l * 9 + cond) * 6144 + (which ? 5120 : 2048) + col];
    const float gate_n = dpp_mov<0xB1>(gate);
    const bool odd = (r & 1) != 0;
    const int colbase = col & ~1;
#pragma unroll
    for (int i = 0; i < 2; ++i)
#pragma unroll
      for (int k = 0; k < 8; ++k) {
        const float lo = acc[i][j][k], hi = acc[i][j][k + 8];
        const float recv = dpp_mov<0xB1>(odd ? lo : hi);
        const int row = m0 + wm * 64 + i * 32 + crow(odd ? k + 8 : k, h);
        f32x2* xp = (f32x2*)(X + (size_t)row * 1024 + colbase);
        const f32x2* xr = first ? (const f32x2*)(row < NCTX ? p.x_prompt + (size_t)row * 1024 + colbase : p.x_sample + (size_t)(row - NCTX) * 1024 + colbase) : (const f32x2*)xp;
        const f32x2 xv = *xr;
        f32x2 o;
        o.x = xv.x + (odd ? gate_n * recv : gate * lo);
        o.y = xv.y + (odd ? gate * hi : gate_n * recv);
        *xp = o;
      }
  }
}
DI void phase_resid(const Params& p, int l, int which, char* smem, int dry) {
  const int xcd = blockIdx.x & 7, local = blockIdx.x >> 3, nloc = gridDim.x >> 3;
  if (nloc == 64) {
    { const int w = local; resid_tile<2>(p, l, which, smem, (xcd * 12 + w % 12) * 128, (w / 12) * 128); }
    { const int w = 64 + (local >> 1); resid_tile<1>(p, l, which, smem, (xcd * 12 + w % 12) * 128, (w / 12) * 128 + (local & 1) * 64); }
  } else {
    int tm, tn;
    for (int it = 0; tile_map(it, 96, 16, tm, tn); ++it) resid_tile<1>(p, l, which, smem, tm * 128, tn * 64);
  }
}

template <int MI, int MODE>
DI void gateup_tile(const Params& p, char* smem, int m0, int n0) {
  const int tid = get_tid(), lane = tid & 63, w = tid >> 6, wm = w >> 1, wn = w & 1, r = lane & 31, h = lane >> 5;
  const bf16_t* H = (const bf16_t*)(p.ws + OFF_H);
  const bf16_t* WT = (const bf16_t*)(p.ws + OFF_WTGU);
  bf16_t* G = (bf16_t*)(p.ws + OFF_G);
  f32x16 acc[MI][2];
  zero_acc<MI, 2>(acc);
  gemm_kloop<MI, 2, MODE>(acc, H + (size_t)m0 * 1024, 1024, WT + (size_t)n0 * 1024, 1024, 1024, (bf16_t*)smem);
  const int col = ((n0 + wn * 64) >> 6) * 32 + r;
#pragma unroll
  for (int i = 0; i < MI; ++i) {
    f32x16 g;
#pragma unroll
    for (int reg = 0; reg < 16; ++reg) g[reg] = siluf_(acc[i][0][reg]) * acc[i][1][reg];
    store_blk_bf16(G, 2816, m0 + wm * 32 * MI + i * 32, col, g, r, h);
  }
}
DI void phase_gateup(const Params& p, char* smem) {
  const int xcd = blockIdx.x & 7, local = blockIdx.x >> 3, nloc = gridDim.x >> 3;
  if (nloc == 64) {
#pragma unroll 1
    for (int it = 0; it < 8; ++it) { const int w = local + it * 64; gateup_tile<2, 3>(p, smem, (xcd * 12 + w % 12) * 128, (w / 12) * 128); }
    if (local < 32) { const int w = 512 + (local >> 1); gateup_tile<1, 3>(p, smem, (xcd * 12 + w % 12) * 128 + (local & 1) * 64, (w / 12) * 128); }
  } else {
    int tm, tn;
    for (int it = 0; tile_map(it, 96, 44, tm, tn); ++it) gateup_tile<2, 3>(p, smem, tm * 128, tn * 128);
  }
}

#define XB_TMO      128
#define XB_XCNT(j)  (256  + 64 * (j))
#define XB_XSUB(j)  (1280 + 64 * (j))
#define XB_XGEN(j)  (2304 + 64 * (j))
#define XB_TOP      3328
#define XB_TOPGEN   3392
#define XCD_BAR_WORDS 3456
#define XB_SPIN_CAP (1u << 18)
#define LAS __attribute__((address_space(3)))
DI unsigned xb_ld(unsigned* p) { return __hip_atomic_load(p, __ATOMIC_RELAXED, __HIP_MEMORY_SCOPE_AGENT); }
DI unsigned xb_add(unsigned* p, unsigned v) { return __hip_atomic_fetch_add(p, v, __ATOMIC_RELAXED, __HIP_MEMORY_SCOPE_AGENT); }
DI unsigned xb_xcc_id() { return (unsigned)__builtin_amdgcn_s_getreg((3 << 11) | 20) & 0xFu; }
#define XB_SPIN(cond, bar) do { unsigned _sp = 0; while (cond) { __builtin_amdgcn_s_sleep(1); \
    if ((++_sp & 255u) == 0u) { if (xb_ld(&(bar)[XB_TMO])) break; if (_sp > XB_SPIN_CAP) { atomicAdd(&(bar)[XB_TMO], 1u); break; } } } } while (0)
struct XcdBarrier { unsigned* bar; unsigned x; volatile LAS unsigned* st; };
DI XcdBarrier xcd_barrier_post(unsigned* bar, volatile LAS unsigned* st) {
  XcdBarrier b; b.bar = bar; b.x = xb_xcc_id(); b.st = st;
  if (threadIdx.x == 0) (void)xb_add(&bar[XB_XCNT(b.x)], 1u);
  return b;
}
DI void xcd_barrier_complete(unsigned* bar, unsigned x, unsigned& nloc, unsigned& nx) {
  const unsigned G = gridDim.x * gridDim.y * gridDim.z;
  unsigned sum, cnt, mine, sp = 0u;
  for (;;) {
    sum = 0u; cnt = 0u; mine = 0u;
#pragma unroll
    for (unsigned j = 0; j < 16; ++j) { const unsigned c = xb_ld(&bar[XB_XCNT(j)]); sum += c; cnt += (c > 0u) ? 1u : 0u; mine = (j == x) ? c : mine; }
    if (sum == G) break;
    __builtin_amdgcn_s_sleep(1);
    if ((++sp & 255u) == 0u) { if (xb_ld(&bar[XB_TMO])) break; if (sp > XB_SPIN_CAP) { atomicAdd(&bar[XB_TMO], 1u); break; } }
  }
  nloc = mine > 0u ? mine : 1u; nx = cnt > 0u ? cnt : 1u;
}
DI void xcd_barrier(const XcdBarrier& b) {
  asm volatile("s_waitcnt vmcnt(0)" ::: "memory");
  __syncthreads();
  if (threadIdx.x == 0) {
    unsigned* bar = b.bar;
    __builtin_amdgcn_s_waitcnt(0);
    unsigned nloc = b.st[0], nx = b.st[1];
    if (nloc == 0u) { xcd_barrier_complete(bar, b.x, nloc, nx); b.st[0] = nloc; b.st[1] = nx; }
    const unsigned old = xb_add(&bar[XB_XSUB(b.x)], 1u);
    const unsigned gen = old / nloc;
    if (old + 1u == (gen + 1u) * nloc) {
      __builtin_amdgcn_fence(__ATOMIC_RELEASE, "agent");
      asm volatile("s_waitcnt vmcnt(0)" ::: "memory");
      const unsigned og = xb_add(&bar[XB_TOP], 1u);
      const unsigned tg = og / nx;
      if (og + 1u == (tg + 1u) * nx) xb_add(&bar[XB_TOPGEN], 1u);
      else XB_SPIN(xb_ld(&bar[XB_TOPGEN]) == tg, bar);
      __builtin_amdgcn_fence(__ATOMIC_ACQUIRE, "agent");
      xb_add(&bar[XB_XGEN(b.x)], 1u);
      asm volatile("s_waitcnt vmcnt(0)" ::: "memory");
    } else {
      XB_SPIN(xb_ld(&bar[XB_XGEN(b.x)]) == gen, bar);
      __builtin_amdgcn_fence(__ATOMIC_ACQUIRE, "agent");
      asm volatile("s_waitcnt vmcnt(0)" ::: "memory");
    }
  }
  __syncthreads();
}

DI void run_phase(const Params& p, int ph, char* smem) {
  if (ph == 0) { phase_prologue(p, smem); phase_convert(p, 0, smem); return; }
  if (ph == NPH - 1) { phase_norm(p, 0, 2); return; }
  const int l = (ph - 1) / 9, s = (ph - 1) % 9;
  switch (s) {
    case 0: if (l > 0) phase_convert(p, l, smem); phase_norm(p, l, 0); break;
    case 1: phase_gemm_in(p, l, smem); break;
    case 2: phase_mixers(p, l, smem, 3, 0, l); break;
    case 3: phase_combine(p, l, 0); break;
    case 4: phase_merge(p, l, smem); break;
    case 5: phase_resid(p, l, 0, smem, 0); break;
    case 6: phase_norm(p, l, 1); break;
    case 7: phase_gateup(p, smem); break;
    default: phase_resid(p, l, 1, smem, 0); break;
  }
}

__global__ void __launch_bounds__(256, 2) hybrid_mega(Params p) {
  char* smem = dyn_smem;
  __shared__ uint4 xb_words;
  if (threadIdx.x == 0) xb_words = make_uint4(0u, 0u, 0u, 0u);
  __syncthreads();
  const XcdBarrier xb = xcd_barrier_post((unsigned*)(p.ws + OFF_BAR), (volatile LAS unsigned*)&xb_words);
  typedef const __attribute__((address_space(4))) Params* kparg_t;
  kparg_t kp = (kparg_t)__builtin_amdgcn_kernarg_segment_ptr();
  const int ph_lo = kp->ph_lo, ph_hi = kp->ph_hi, use_cg = kp->use_cg;
  for (int ph = ph_lo; ph < ph_hi; ++ph) {
    asm volatile("" : "+s"(kp));
    run_phase(*(const Params*)kp, ph, smem);
    if (ph + 1 < ph_hi) {
      if (use_cg) cg::this_grid().sync();
      else xcd_barrier(xb);
    }
  }
}

extern "C" void kernel_launch(void* const* d_in, const int* in_sizes, int n_in, void* d_out, int out_size, void* d_ws, size_t ws_size,
                              hipStream_t stream) {
  if (ws_size < WS_TOTAL || n_in < 30) { fprintf(stderr, "workspace too small: %zu < %zu\n", ws_size, (size_t)WS_TOTAL); return; }
  Params p{};
  const float** pp = (const float**)&p;
  for (int i = 0; i < 30; ++i) pp[i] = (const float*)d_in[i];
  p.out = (float*)d_out;
  p.ws = (char*)d_ws;
  static int grid_blocks = 0;
  if (!grid_blocks) {
    int dev = 0, cus = 0, per_cu = 0;
    hipGetDevice(&dev);
    hipDeviceGetAttribute(&cus, hipDeviceAttributeMultiprocessorCount, dev);
    hipFuncSetAttribute((const void*)hybrid_mega, hipFuncAttributeMaxDynamicSharedMemorySize, SMEM_BYTES);
    hipOccupancyMaxActiveBlocksPerMultiprocessor(&per_cu, hybrid_mega, 256, SMEM_BYTES);
    if (per_cu > 2) per_cu = 2;
    if (per_cu < 1) per_cu = 1;
    grid_blocks = (cus * per_cu) & ~7;
  }
  hipMemsetAsync((char*)d_ws + OFF_BAR, 0, 16384 + 65536, stream);
#if FUSED
#ifndef PROBE_MASK
#define PROBE_MASK 0
#endif
  p.ph_lo = 0; p.ph_hi = NPH; p.use_cg = 0; p.pad_ = PROBE_MASK;
  void* args[] = {&p};
  hipError_t e = hipLaunchCooperativeKernel((void*)hybrid_mega, dim3(grid_blocks), dim3(256), args, SMEM_BYTES, stream);
  if (e != hipSuccess) fprintf(stderr, "cooperative launch failed: %s (grid %d)\n", hipGetErrorString(e), grid_blocks);
#else
  for (int ph = 0; ph < NPH; ++ph) {
    p.ph_lo = ph; p.ph_hi = ph + 1;
    hipLaunchKernelGGL(hybrid_mega, dim3(grid_blocks), dim3(256), SMEM_BYTES, stream, p);
  }
#endif
}
#ifdef RESOURCE_PROBE
#define PROBE_K(name, body) __global__ void __launch_bounds__(256, 2) name(Params p) { char* smem = dyn_smem; body; }
PROBE_K(k_prologue, phase_prologue(p, smem))
PROBE_K(k_norm, phase_norm(p, p.ph_lo, p.ph_hi))
PROBE_K(k_convert, phase_convert(p, p.ph_lo, smem))
PROBE_K(k_gemm_in, phase_gemm_in(p, p.ph_lo, smem))
PROBE_K(k_gdn, gdn_item(p, p.ph_lo, p.ph_hi & 1, 1, 2, p.ph_hi & 2, 1, smem))
PROBE_K(k_hgrn, hgrn_item(p, p.ph_lo, p.ph_hi & 1, 1, 2, p.ph_hi & 2, 1, smem))
PROBE_K(k_diff, diff_item(p, p.ph_lo, p.ph_hi & 1, 1, 2, 3, smem, 0))
PROBE_K(k_na, na_item(p, p.ph_lo, p.ph_hi & 1, 1, 2, 3, smem, 0))
PROBE_K(k_combine, phase_combine(p, p.ph_lo, 0))
PROBE_K(k_merge, phase_merge(p, p.ph_lo, smem))
PROBE_K(k_resid, phase_resid(p, p.ph_lo, p.ph_hi, smem, 0))
PROBE_K(k_gateup, phase_gateup(p, smem))
#endif
#ifdef RESOURCE_PROBE
PROBE_K(k_mixers, phase_mixers(p, p.ph_lo, smem, 3, 0, 0))
__global__ void __launch_bounds__(256, 2) k_nomix(Params p) {
  char* smem = dyn_smem;
  cg::grid_group grid = cg::this_grid();
  for (int ph = p.ph_lo; ph < p.ph_hi; ++ph) { if ((ph - 1) % 9 != 2) run_phase(p, ph, smem); if (ph + 1 < p.ph_hi) grid.sync(); }
}
#endif
```

```cpp
#include <hip/hip_runtime.h>
#include <hip/hip_cooperative_groups.h>
#include <cstdio>
#include <cstdint>
namespace cg = cooperative_groups;

#ifndef FUSED
#define FUSED 1
#endif

#define DI __device__ __forceinline__
typedef unsigned short bf16_t;
typedef short bf16x8 __attribute__((ext_vector_type(8)));
typedef short s16x4 __attribute__((ext_vector_type(4)));
typedef float f32x16 __attribute__((ext_vector_type(16)));
typedef unsigned u32x4 __attribute__((ext_vector_type(4)));
typedef unsigned u32x2 __attribute__((ext_vector_type(2)));
typedef float f32x4 __attribute__((ext_vector_type(4)));

constexpr int NTOK = 12288, NCTX = 4096, PS = 7808;
constexpr int C_AQ = 0, C_AK = 512, C_AV = 1024, C_AZ = 1536, C_BQ = 2048, C_BK = 2560, C_BV = 3072, C_CQ = 3584, C_CF = 4096,
              C_CI = 5120, C_CG = 5632, C_DQ = 6144, C_DK = 6656, C_DV = 7168, C_AA = 7680, C_AB = 7688;
constexpr int NPH = 20;
constexpr int SMEM_BYTES = 73728;

constexpr size_t OFF_CTR = 0;
constexpr size_t OFF_MOD = 4096;
constexpr size_t OFF_ROPE = OFF_MOD + (size_t)2 * 9 * 6144 * 4;
constexpr size_t OFF_LB = OFF_ROPE + (size_t)2 * 1024 * 32 * 4;
constexpr size_t OFF_H = OFF_LB + 8192;
constexpr size_t OFF_P = OFF_H + (size_t)NTOK * 1024 * 2;
constexpr size_t OFF_WTIN = OFF_P + (size_t)NTOK * PS * 2;
constexpr size_t OFF_WTBR = OFF_WTIN + (size_t)11904 * 1024 * 2;
constexpr size_t OFF_WTOUT = OFF_WTBR + (size_t)4 * 1024 * 512 * 2;
constexpr size_t OFF_WTGU = OFF_WTOUT + (size_t)1024 * 1024 * 2;
constexpr size_t OFF_WTDN = OFF_WTGU + (size_t)5632 * 1024 * 2;
constexpr size_t OFF_OD = OFF_WTDN + (size_t)1024 * 2816 * 2;
constexpr size_t OFF_VTB = OFF_OD + (size_t)4 * NTOK * 512 * 2;
constexpr size_t OFF_VTD = OFF_VTB + (size_t)NTOK * 512 * 2;
constexpr size_t OFF_VTCB = OFF_VTD + (size_t)NTOK * 512 * 2;
constexpr size_t OFF_VTCD = OFF_VTCB + (size_t)8 * 512 * 512 * 2;
constexpr size_t OFF_BAR = OFF_VTCD + (size_t)8 * 512 * 512 * 2;
constexpr size_t OFF_CUCTR = OFF_BAR + 16384;
constexpr size_t WS_TOTAL = OFF_CUCTR + 65536;
constexpr size_t OFF_M = OFF_OD;
constexpr size_t OFF_G = OFF_P;

constexpr size_t O_SGDN = 12582912, O_DK = 16777216, O_DV = 20971520, O_SHGRN = 25165824, O_NK = 29360128, O_NV = 33554432;

extern __shared__ __attribute__((aligned(16))) char dyn_smem[];

struct Params {
  const float *x_prompt, *x_sample, *c, *state_gdn, *cache_diff_k, *cache_diff_v, *state_hgrn, *cache_na_k, *cache_na_v, *c_ctx,
      *w_ada, *b_ada, *norm1_g, *w_in, *gdn_conv_w, *gdn_A_log, *gdn_dt_bias, *gdn_norm_g, *diff_lambda, *diff_norm_g,
      *hgrn_lb_logits, *hgrn_norm_g, *na_rpb, *w_branch, *w_out, *norm2_g, *w_ffn_gate, *w_ffn_up, *w_ffn_down, *final_norm_g;
  float* out;
  char* ws;
  int ph_lo, ph_hi, use_cg, pad_;
};

typedef __bf16 hbf16x2 __attribute__((ext_vector_type(2)));
DI bf16_t f2bf(float x) { return __builtin_bit_cast(bf16_t, (__bf16)x); }
DI float bf2f(bf16_t v) { return __uint_as_float(((unsigned)v) << 16); }
DI unsigned pack2(float a, float b) { typedef float f2v __attribute__((ext_vector_type(2))); const f2v f = {a, b}; return __builtin_bit_cast(unsigned, __builtin_convertvector(f, hbf16x2)); }
DI float lo2f(unsigned u) { return __uint_as_float(u << 16); }
DI float hi2f(unsigned u) { return __uint_as_float(u & 0xffff0000u); }
DI void unpack8(const u32x4& v, float* x) {
  x[0] = lo2f(v.x); x[1] = hi2f(v.x); x[2] = lo2f(v.y); x[3] = hi2f(v.y);
  x[4] = lo2f(v.z); x[5] = hi2f(v.z); x[6] = lo2f(v.w); x[7] = hi2f(v.w);
}
DI u32x4 pack8(const float* x) { u32x4 v; v.x = pack2(x[0], x[1]); v.y = pack2(x[2], x[3]); v.z = pack2(x[4], x[5]); v.w = pack2(x[6], x[7]); return v; }
DI int get_tid() { int t = threadIdx.x; asm volatile("" : "+v"(t)); return t; }
DI int lrow(int v) { asm volatile("" : "+v"(v)); return v; }
DI float wave_sum(float v) {
#pragma unroll
  for (int o = 32; o > 0; o >>= 1) v += __shfl_xor(v, o);
  return v;
}

typedef float f32x2 __attribute__((ext_vector_type(2)));
template <int CTRL> DI float dpp_mov(float v) { return __builtin_bit_cast(float, __builtin_amdgcn_update_dpp(0, __builtin_bit_cast(int, v), CTRL, 0xF, 0xF, true)); }
DI float red8(float v) { v += dpp_mov<0xB1>(v); v += dpp_mov<0x4E>(v); v += dpp_mov<0x141>(v); return v; }
DI float rdl(float v, int l) { return __builtin_bit_cast(float, __builtin_amdgcn_readlane(__builtin_bit_cast(int, v), l)); }
DI float wave_sum_fast(float v) { v = red8(v); v += dpp_mov<0x140>(v); return (rdl(v, 0) + rdl(v, 16)) + (rdl(v, 32) + rdl(v, 48)); }
DI void ld16(const float* p, f32x2 (&o)[8]) {
#pragma unroll
  for (int i = 0; i < 4; ++i) { const f32x4 a = *(const f32x4*)(p + 4 * i); o[2 * i] = (f32x2){a.x, a.y}; o[2 * i + 1] = (f32x2){a.z, a.w}; }
}
DI unsigned xb_xcc_id();
DI float sigmoidf_(float x) { return __builtin_amdgcn_rcpf(1.f + __expf(-x)); }
DI float siluf_(float x) { return x * __builtin_amdgcn_rcpf(1.f + __expf(-x)); }
DI int crow(int reg, int h) { return (reg & 3) + 8 * (reg >> 2) + 4 * h; }
#define MFMA32(a, b, c) __builtin_amdgcn_mfma_f32_32x32x16_bf16((a), (b), (c), 0, 0, 0)


DI void store_blk_bf16(bf16_t* base, size_t ld, int row0, int col, const f32x16& a, int r, int h) {
  const bool odd = (r & 1) != 0;
  const int colbase = col & ~1;
#pragma unroll
  for (int k = 0; k < 8; ++k) {
    const float lo = a[k], hi = a[k + 8];
    const float recv = dpp_mov<0xB1>(odd ? lo : hi);
    const int row = row0 + crow(odd ? k + 8 : k, h);
    __builtin_nontemporal_store(odd ? pack2(recv, hi) : pack2(lo, recv), (unsigned*)(base + (size_t)row * ld + colbase));
  }
}
template <int MI, int NJ>
DI void gemm_ld(u32x4 (&ra)[2 * MI], u32x4 (&rb)[2 * NJ], const bf16_t* A, int lda, const bf16_t* B, int ldb, int k0, int lr, int lc, int bgs = 32) {
#pragma unroll
  for (int i = 0; i < 2 * MI; ++i) ra[i] = *(const u32x4*)(A + (size_t)(lr + 32 * i) * lda + k0 + lc);
#pragma unroll
  for (int i = 0; i < 2 * NJ; ++i) rb[i] = *(const u32x4*)(B + (size_t)(lr + bgs * i) * ldb + k0 + lc);
}
template <int MI, int NJ>
DI void gemm_st(const u32x4 (&ra)[2 * MI], const u32x4 (&rb)[2 * NJ], bf16_t* As, bf16_t* Bs, int lr, int lc) {
#pragma unroll
  for (int i = 0; i < 2 * MI; ++i) *(u32x4*)(As + (lr + 32 * i) * 72 + lc) = ra[i];
#pragma unroll
  for (int i = 0; i < 2 * NJ; ++i) *(u32x4*)(Bs + (lr + 32 * i) * 72 + lc) = rb[i];
}
template <int MI, int NJ>
DI void gemm_mm(f32x16 (&acc)[MI][NJ], const bf16_t* As, const bf16_t* Bs, int wm, int wn, int r, int h) {
  __builtin_amdgcn_s_setprio(1);
#pragma unroll
  for (int ks = 0; ks < 4; ++ks) {
    bf16x8 a[MI], b[NJ];
#pragma unroll
    for (int i = 0; i < MI; ++i) a[i] = *(const bf16x8*)(As + (wm * 32 * MI + i * 32 + r) * 72 + ks * 16 + h * 8);
#pragma unroll
    for (int j = 0; j < NJ; ++j) b[j] = *(const bf16x8*)(Bs + (wn * 32 * NJ + j * 32 + r) * 72 + ks * 16 + h * 8);
#pragma unroll
    for (int i = 0; i < MI; ++i)
#pragma unroll
      for (int j = 0; j < NJ; ++j) acc[i][j] = MFMA32(a[i], b[j], acc[i][j]);
  }
  __builtin_amdgcn_s_setprio(0);
}
template <int MI, int NJ>
DI void gemm_dma(const bf16_t* A, int lda, const bf16_t* B, int ldb, int k0, char* stage, int tid, int bgs) {
  const int lr = tid >> 3, gch = ((tid & 7) ^ (lr & 7)) * 8;
#pragma unroll
  for (int i = 0; i < 2 * MI; ++i)
    __builtin_amdgcn_global_load_lds((const unsigned*)(A + (size_t)(lr + 32 * i) * lda + k0 + gch), (unsigned*)(stage + tid * 16 + i * 4096), 16, 0, 0);
#pragma unroll
  for (int i = 0; i < 2 * NJ; ++i)
    __builtin_amdgcn_global_load_lds((const unsigned*)(B + (size_t)(lr + bgs * i) * ldb + k0 + gch), (unsigned*)(stage + 64 * MI * 128 + tid * 16 + i * 4096), 16, 0, 0);
}
template <int MI, int NJ>
DI void gemm_mm3(f32x16 (&acc)[MI][NJ], const char* As, const char* Bs, int wm, int wn, int r, int h) {
  __builtin_amdgcn_s_setprio(1);
#pragma unroll
  for (int ks = 0; ks < 4; ++ks) {
    bf16x8 a[MI], b[NJ];
#pragma unroll
    for (int i = 0; i < MI; ++i) { const int R = wm * 32 * MI + i * 32 + r; a[i] = *(const bf16x8*)(As + R * 128 + (((ks * 2 + h) ^ (R & 7)) << 4)); }
#pragma unroll
    for (int j = 0; j < NJ; ++j) { const int R = wn * 32 * NJ + j * 32 + r; b[j] = *(const bf16x8*)(Bs + R * 128 + (((ks * 2 + h) ^ (R & 7)) << 4)); }
#pragma unroll
    for (int i = 0; i < MI; ++i)
#pragma unroll
      for (int j = 0; j < NJ; ++j) acc[i][j] = MFMA32(a[i], b[j], acc[i][j]);
  }
  __builtin_amdgcn_s_setprio(0);
}
template <int MI, int NJ, int MODE = 0>
DI void gemm_kloop(f32x16 (&acc)[MI][NJ], const bf16_t* A, int lda, const bf16_t* B, int ldb, int K, bf16_t* sm, int bgs = 32) {
  const int tid = get_tid(), lane = tid & 63, w = tid >> 6, wm = w >> 1, wn = w & 1, r = lane & 31, h = lane >> 5;
  const int lr = tid >> 3, lc = (tid & 7) * 8;
  const int nk = K >> 6;
  if (MODE == 3) {
    constexpr int STGB = (64 * MI + 64 * NJ) * 128;
    char* smb = (char*)sm;
    __syncthreads();
    gemm_dma<MI, NJ>(A, lda, B, ldb, 0, smb, tid, bgs);
    asm volatile("s_waitcnt vmcnt(0)" ::: "memory");
    __syncthreads();
    for (int kt = 0; kt < nk; ++kt) {
      char* cs = smb + (kt & 1) * STGB;
      if (kt + 1 < nk) gemm_dma<MI, NJ>(A, lda, B, ldb, (kt + 1) * 64, smb + ((kt + 1) & 1) * STGB, tid, bgs);
      gemm_mm3<MI, NJ>(acc, cs, cs + 64 * MI * 128, wm, wn, r, h);
      asm volatile("s_waitcnt vmcnt(0)" ::: "memory");
      __syncthreads();
    }
    return;
  }
  u32x4 ra[2 * MI], rb[2 * NJ];
  gemm_ld<MI, NJ>(ra, rb, A, lda, B, ldb, 0, lr, lc, bgs);
  if (MODE == 2) {
    constexpr int STG = (64 * MI + 64 * NJ) * 72;
    __syncthreads();
    gemm_st<MI, NJ>(ra, rb, sm, sm + 64 * MI * 72, lr, lc);
    if (nk > 1) gemm_ld<MI, NJ>(ra, rb, A, lda, B, ldb, 64, lr, lc, bgs);
    __syncthreads();
    for (int kt = 0; kt < nk; ++kt) {
      bf16_t* cs = sm + (kt & 1) * STG;
      bf16_t* ns = sm + ((kt + 1) & 1) * STG;
      if (kt + 1 < nk) gemm_st<MI, NJ>(ra, rb, ns, ns + 64 * MI * 72, lr, lc);
      if (kt + 2 < nk) gemm_ld<MI, NJ>(ra, rb, A, lda, B, ldb, (kt + 2) * 64, lr, lc, bgs);
      gemm_mm<MI, NJ>(acc, cs, cs + 64 * MI * 72, wm, wn, r, h);
      __syncthreads();
    }
  } else if (MODE == 1) {
    bf16_t* As = sm;
    bf16_t* Bs = sm + 64 * MI * 72;
    u32x4 ra2[2 * MI], rb2[2 * NJ];
    gemm_ld<MI, NJ>(ra2, rb2, A, lda, B, ldb, 64, lr, lc, bgs);
    for (int kt = 0; kt < nk; kt += 2) {
      __syncthreads();
      gemm_st<MI, NJ>(ra, rb, As, Bs, lr, lc);
      __syncthreads();
      if (kt + 2 < nk) gemm_ld<MI, NJ>(ra, rb, A, lda, B, ldb, (kt + 2) * 64, lr, lc, bgs);
      gemm_mm<MI, NJ>(acc, As, Bs, wm, wn, r, h);
      __syncthreads();
      gemm_st<MI, NJ>(ra2, rb2, As, Bs, lr, lc);
      __syncthreads();
      if (kt + 3 < nk) gemm_ld<MI, NJ>(ra2, rb2, A, lda, B, ldb, (kt + 3) * 64, lr, lc, bgs);
      gemm_mm<MI, NJ>(acc, As, Bs, wm, wn, r, h);
    }
  } else {
    bf16_t* As = sm;
    bf16_t* Bs = sm + 64 * MI * 72;
    for (int kt = 0; kt < nk; ++kt) {
      __syncthreads();
      gemm_st<MI, NJ>(ra, rb, As, Bs, lr, lc);
      __syncthreads();
      if (kt + 1 < nk) gemm_ld<MI, NJ>(ra, rb, A, lda, B, ldb, (kt + 1) * 64, lr, lc, bgs);
      gemm_mm<MI, NJ>(acc, As, Bs, wm, wn, r, h);
    }
  }
}

template <int MI, int NJ>
DI void zero_acc(f32x16 (&acc)[MI][NJ]) {
#pragma unroll
  for (int i = 0; i < MI; ++i)
#pragma unroll
    for (int j = 0; j < NJ; ++j)
#pragma unroll
      for (int r = 0; r < 16; ++r) acc[i][j][r] = 0.f;
}

DI bool tile_map(int it, int MT, int NT, int& tm, int& tn) {
  const int xcd = blockIdx.x & 7, local = blockIdx.x >> 3, nloc = gridDim.x >> 3, mper = MT >> 3;
  const int w = local + it * nloc;
  if (w >= mper * NT) return false;
  tn = w / mper;
  tm = xcd * mper + (w % mper);
  return true;
}

DI int cond_of_row(int row) { return row < NCTX ? 8 : ((row - NCTX) >> 10); }

DI void phase_prologue(const Params& p, char* smem) {
  const int tid = get_tid(), lane = tid & 63, w = tid >> 6;
  const int gtid = blockIdx.x * 256 + tid, gsz = gridDim.x * 256;
  float* consts = (float*)(p.ws + OFF_CTR);
  if (blockIdx.x == 0) {
    if (tid < 8) ((unsigned*)consts)[tid] = 0u;
    if (tid >= 32 && tid < 64) ((unsigned*)consts)[tid] = 0u;
    if (w == 1) {
      for (int l = 0; l < 2; ++l) {
        const float* dl = p.diff_lambda + l * 256;
        float a = dl[lane] * dl[64 + lane], b = dl[128 + lane] * dl[192 + lane];
        a = wave_sum(a); b = wave_sum(b);
        const float li = 0.8f - 0.6f * expf(-0.3f * (float)l);
        if (lane == 0) { consts[16 + l] = expf(a) - expf(b) + li; consts[18 + l] = 1.f - li; }
      }
    }
  }
  {
    float* rc = (float*)(p.ws + OFF_ROPE);
    float* rs = rc + 1024 * 32;
    for (int i = gtid; i < 1024 * 32; i += gsz) {
      const int t = i >> 5, pp = i & 31;
      const float inv = powf(10000.f, -(float)(pp & 15) / 16.f);
      const float pos = pp < 16 ? (float)(t >> 6) : (float)(t & 63);
      const float ang = pos * inv;
      rc[i] = cosf(ang); rs[i] = sinf(ang);
    }
  }
  {
    float* LB = (float*)(p.ws + OFF_LB);
    for (int i = gtid; i < 1024; i += gsz) {
      const float x0 = p.hgrn_lb_logits[i], x1 = p.hgrn_lb_logits[1024 + i];
      const float m = fmaxf(x0, x1), e0 = expf(x0 - m), e1 = expf(x1 - m);
      LB[i] = 0.f; LB[1024 + i] = e1 / (e0 + e1);
    }
  }
  {
    float* sc = (float*)smem;
    float* red = sc + 9 * 1024;
    float* MOD = (float*)(p.ws + OFF_MOD);
    bool filled = false;
    for (int item = blockIdx.x; item < 192; item += gridDim.x) {
      if (!filled) {
        for (int i = tid; i < 9 * 1024; i += 256) { const int c = i >> 10, k = i & 1023; const float v = c < 8 ? p.c[c * 1024 + k] : p.c_ctx[k]; sc[i] = siluf_(v); }
        filled = true;
      }
      __syncthreads();
      const int l = item / 96, cg0 = (item % 96) * 64;
      const int kq = tid >> 4, c4 = tid & 15;
      float acc[9][4];
#pragma unroll
      for (int c = 0; c < 9; ++c)
#pragma unroll
        for (int e = 0; e < 4; ++e) acc[c][e] = 0.f;
      const float* wp = p.w_ada + ((size_t)l * 1024 + kq * 64) * 6144 + cg0 + c4 * 4;
#pragma unroll 4
      for (int k = 0; k < 64; ++k) {
        const f32x4 wv = *(const f32x4*)(wp + (size_t)k * 6144);
#pragma unroll
        for (int c = 0; c < 9; ++c) {
          const float s = sc[c * 1024 + kq * 64 + k];
          acc[c][0] += s * wv.x; acc[c][1] += s * wv.y; acc[c][2] += s * wv.z; acc[c][3] += s * wv.w;
        }
      }
#pragma unroll
      for (int c = 0; c < 9; ++c)
#pragma unroll
        for (int e = 0; e < 4; ++e) { float v = acc[c][e]; v += __shfl_xor(v, 16); v += __shfl_xor(v, 32); acc[c][e] = v; }
      if (lane < 16) {
#pragma unroll
        for (int c = 0; c < 9; ++c)
#pragma unroll
          for (int e = 0; e < 4; ++e) red[(w * 9 + c) * 64 + c4 * 4 + e] = acc[c][e];
      }
      __syncthreads();
      for (int i = tid; i < 9 * 64; i += 256) {
        const int c = i >> 6, col = i & 63;
        const float v = red[(0 * 9 + c) * 64 + col] + red[(1 * 9 + c) * 64 + col] + red[(2 * 9 + c) * 64 + col] + red[(3 * 9 + c) * 64 + col];
        MOD[((size_t)l * 9 + c) * 6144 + cg0 + col] = v + p.b_ada[l * 6144 + cg0 + col];
      }
    }
  }
}

DI void phase_norm(const Params& p, int l, int which) {
  const int tid = get_tid(), lane = tid & 63, w = tid >> 6;
  float* X = p.out;
  bf16_t* H = (bf16_t*)(p.ws + OFF_H);
  const float* MOD = (const float*)(p.ws + OFF_MOD);
  for (int it = blockIdx.x; it < NTOK / 4; it += gridDim.x) {
    const int row = it * 4 + w;
    const float* xsrc = (which == 0 && l == 0) ? (row < NCTX ? p.x_prompt + (size_t)row * 1024 : p.x_sample + (size_t)(row - NCTX) * 1024) : X + (size_t)row * 1024;
    f32x4 x[4];
    float ss = 0.f;
#pragma unroll
    for (int i = 0; i < 4; ++i) {
      x[i] = *(const f32x4*)(xsrc + i * 256 + lane * 4);
      ss += x[i].x * x[i].x + x[i].y * x[i].y + x[i].z * x[i].z + x[i].w * x[i].w;
    }
    ss = wave_sum(ss);
    const float rstd = rsqrtf(ss * (1.f / 1024.f) + 1e-6f);
    if (which == 2) {
#pragma unroll
      for (int i = 0; i < 4; ++i) {
        const int col = i * 256 + lane * 4;
        const f32x4 g = *(const f32x4*)(p.final_norm_g + col);
        f32x4 y; y.x = x[i].x * rstd * g.x; y.y = x[i].y * rstd * g.y; y.z = x[i].z * rstd * g.z; y.w = x[i].w * rstd * g.w;
        *(f32x4*)(X + (size_t)row * 1024 + col) = y;
      }
    } else {
      const int cond = cond_of_row(row);
      const float* msh = MOD + ((size_t)l * 9 + cond) * 6144 + (which ? 3072 : 0);
      const float* msc = msh + 1024;
      const float* gg = (which ? p.norm2_g : p.norm1_g) + l * 1024;
#pragma unroll
      for (int i = 0; i < 4; ++i) {
        const int col = i * 256 + lane * 4;
        const f32x4 g = *(const f32x4*)(gg + col), sh = *(const f32x4*)(msh + col), sc = *(const f32x4*)(msc + col);
        const float y0 = x[i].x * rstd * g.x * (1.f + sc.x) + sh.x, y1 = x[i].y * rstd * g.y * (1.f + sc.y) + sh.y;
        const float y2 = x[i].z * rstd * g.z * (1.f + sc.z) + sh.z, y3 = x[i].w * rstd * g.w * (1.f + sc.w) + sh.w;
        u32x2 o; o.x = pack2(y0, y1); o.y = pack2(y2, y3);
        *(u32x2*)(H + (size_t)row * 1024 + col) = o;
      }
    }
  }
}

DI int map_row(int n, int map) {
  if (map == 0) return n;
  if (map == 1) return n < 2048 ? n : (n < 2064 ? 7680 + (n - 2048) : (n < 7696 ? n - 16 : n + 112));
  if (map == 2) return 64 * (n >> 5) + (n & 31);
  return 64 * (n >> 5) + 32 + (n & 31);
}
struct TDesc { const float* src; bf16_t* dst; int src_ld, nmax, k0, n0, dst_ld, map; };
DI TDesc conv_desc(const Params& p, int l, int item) {
  constexpr int N0 = 2960, N1 = N0 + 512, N2 = N1 + 256, N3 = N2 + 704, N4 = N3 + 704, N5 = N4 + 704, N6 = N5 + 512;
  TDesc d;
  if (item < N0) {
    const int kt = item & 15, nt = item >> 4;
    d = {p.w_in + (size_t)l * 1024 * 11792, (bf16_t*)(p.ws + OFF_WTIN), 11792, 11792, kt * 64, nt * 64, 1024, 1};
  } else if (item < N1) {
    const int j = item - N0, br = j >> 7, r = j & 127, kt = r & 7, nt = r >> 3;
    d = {p.w_branch + ((size_t)(l * 4 + br) * 512) * 1024, (bf16_t*)(p.ws + OFF_WTBR) + (size_t)br * 1024 * 512, 1024, 1024, kt * 64, nt * 64, 512, 0};
  } else if (item < N2) {
    const int j = item - N1, kt = j & 15, nt = j >> 4;
    d = {p.w_out + (size_t)l * 1024 * 1024, (bf16_t*)(p.ws + OFF_WTOUT), 1024, 1024, kt * 64, nt * 64, 1024, 0};
  } else if (item < N3) {
    const int j = item - N2, kt = j & 15, nt = j >> 4;
    d = {p.w_ffn_gate + (size_t)l * 1024 * 2816, (bf16_t*)(p.ws + OFF_WTGU), 2816, 2816, kt * 64, nt * 64, 1024, 2};
  } else if (item < N4) {
    const int j = item - N3, kt = j & 15, nt = j >> 4;
    d = {p.w_ffn_up + (size_t)l * 1024 * 2816, (bf16_t*)(p.ws + OFF_WTGU), 2816, 2816, kt * 64, nt * 64, 1024, 3};
  } else if (item < N5) {
    const int j = item - N4, kt = j % 44, nt = j / 44;
    d = {p.w_ffn_down + (size_t)l * 2816 * 1024, (bf16_t*)(p.ws + OFF_WTDN), 1024, 1024, kt * 64, nt * 64, 2816, 0};
  } else if (item < N6) {
    const int j = item - N5, bh = j >> 4, r = j & 15, kt = r & 7, nt = r >> 3, b = bh >> 2, h = bh & 3;
    d = {p.cache_diff_v + ((size_t)((b * 2 + l) * 4 + h) * 512) * 128, (bf16_t*)(p.ws + OFF_VTCB) + (size_t)bh * 128 * 512, 128, 128, kt * 64, nt * 64, 512, 0};
  } else {
    const int j = item - N6, bh = j >> 3, kt = j & 7, b = bh >> 3, h = bh & 7;
    d = {p.cache_na_v + ((size_t)((b * 2 + l) * 8 + h) * 512) * 64, (bf16_t*)(p.ws + OFF_VTCD) + (size_t)bh * 64 * 512, 64, 64, kt * 64, 0, 512, 0};
  }
  return d;
}
DI void conv_load(const TDesc& d, int tid, f32x4 (&v)[4]) {
#pragma unroll
  for (int i = 0; i < 4; ++i) {
    const int k = i * 16 + (tid >> 4), n4 = (tid & 15) * 4;
    v[i] = (f32x4){0.f, 0.f, 0.f, 0.f};
    if (d.n0 + n4 < d.nmax) v[i] = *(const f32x4*)(d.src + (size_t)(d.k0 + k) * d.src_ld + d.n0 + n4);
  }
}
DI void conv_store(const TDesc& d, int tid, const f32x4 (&v)[4], float* tile) {
  __syncthreads();
#pragma unroll
  for (int i = 0; i < 4; ++i) {
    const int k = i * 16 + (tid >> 4), n4 = (tid & 15) * 4;
    tile[k * 65 + n4] = v[i].x; tile[k * 65 + n4 + 1] = v[i].y; tile[k * 65 + n4 + 2] = v[i].z; tile[k * 65 + n4 + 3] = v[i].w;
  }
  __syncthreads();
#pragma unroll
  for (int i = 0; i < 2; ++i) {
    const int n = i * 32 + (tid >> 3), k8 = (tid & 7) * 8;
    if (d.n0 + n < d.nmax) {
      float x[8];
#pragma unroll
      for (int e = 0; e < 8; ++e) x[e] = tile[(k8 + e) * 65 + n];
      *(u32x4*)(d.dst + (size_t)map_row(d.n0 + n, d.map) * d.dst_ld + d.k0 + k8) = pack8(x);
    }
  }
}
DI void phase_convert(const Params& p, int l, char* smem) {
  float* tile = (float*)smem;
  const int tid = get_tid();
  constexpr int NALL = 2960 + 512 + 256 + 704 * 3 + 512 + 512;
  if (blockIdx.x == gridDim.x - 1) {
    u32x4* z = (u32x4*)((bf16_t*)(p.ws + OFF_WTIN) + (size_t)7696 * 1024);
    const u32x4 zero = {0u, 0u, 0u, 0u};
    for (int i = tid; i < 112 * 1024 / 8; i += 256) z[i] = zero;
  }
  int item = blockIdx.x;
  asm volatile("" : "+s"(item));
  if (item >= NALL) return;
  f32x4 v[4];
  { const TDesc d = conv_desc(p, l, lrow(item)); conv_load(d, tid, v); }
  for (;;) {
    const int nitem = item + gridDim.x;
    f32x4 vn[4];
    if (nitem < NALL) { const TDesc dn = conv_desc(p, l, lrow(nitem)); conv_load(dn, tid, vn); }
    { const TDesc d = conv_desc(p, l, lrow(item)); conv_store(d, tid, v, tile); }
    if (nitem >= NALL) break;
    item = nitem;
#pragma unroll
    for (int i = 0; i < 4; ++i) v[i] = vn[i];
  }
}

DI void phase_gemm_in(const Params& p, int l, char* smem) {
  const int tid = get_tid(), lane = tid & 63, w = tid >> 6, wm = w >> 1, wn = w & 1, r = lane & 31, h = lane >> 5;
  const bf16_t* H = (const bf16_t*)(p.ws + OFF_H);
  const bf16_t* WT = (const bf16_t*)(p.ws + OFF_WTIN);
  bf16_t* P = (bf16_t*)(p.ws + OFF_P);
  bf16_t* VTB = (bf16_t*)(p.ws + OFF_VTB);
  bf16_t* VTD = (bf16_t*)(p.ws + OFF_VTD);
  int tm, tn;
  for (int it = 0; tile_map(it, 96, 61, tm, tn); ++it) {
    f32x16 acc[2][2];
    zero_acc<2, 2>(acc);
    const int m0 = tm * 128, n0 = tn * 128;
    gemm_kloop<2, 2, 3>(acc, H + (size_t)m0 * 1024, 1024, WT + (size_t)n0 * 1024, 1024, 1024, (bf16_t*)smem);
    const bool isbv = (n0 >= C_BV && n0 < C_CQ), isdv = (n0 >= C_DV && n0 < C_AA);
    if (isbv || isdv) {
      bf16_t* VT = isbv ? VTB : VTD;
      const int cbase = isbv ? C_BV : C_DV;
#pragma unroll
      for (int i = 0; i < 2; ++i)
#pragma unroll
        for (int j = 0; j < 2; ++j) {
          const int c = n0 + wn * 64 + j * 32 + r - cbase;
#pragma unroll
          for (int g = 0; g < 4; ++g) {
            const int rb = m0 + wm * 64 + i * 32 + 8 * g + 4 * h;
            size_t off;
            if (rb < NCTX) off = ((size_t)(rb >> 8) * 512 + c) * 256 + (rb & 255);
            else { const int r2 = rb - NCTX; off = (size_t)2097152 + ((size_t)(r2 >> 10) * 512 + c) * 1024 + (r2 & 1023); }
            u32x2 v; v.x = pack2(acc[i][j][4 * g], acc[i][j][4 * g + 1]); v.y = pack2(acc[i][j][4 * g + 2], acc[i][j][4 * g + 3]);
            *(u32x2*)(VT + off) = v;
          }
        }
    } else {
#pragma unroll
      for (int i = 0; i < 2; ++i)
#pragma unroll
        for (int j = 0; j < 2; ++j) {
          store_blk_bf16(P, PS, m0 + wm * 64 + i * 32, n0 + wn * 64 + j * 32 + r, acc[i][j], r, h);
        }
    }
    if (m0 < NCTX) {
      const bool isbk = (n0 >= C_BK && n0 < C_BV), isdk = (n0 >= C_DK && n0 < C_DV);
      if (isbk || isbv || isdk || isdv) {
        float* o = p.out + (isbk ? O_DK : isbv ? O_DV : isdk ? O_NK : O_NV);
        const int cbase = isbk ? C_BK : isbv ? C_BV : isdk ? C_DK : C_DV;
        const bool wide = isbk || isbv;
#pragma unroll
        for (int i = 0; i < 2; ++i)
#pragma unroll
          for (int j = 0; j < 2; ++j) {
            const int c = n0 + wn * 64 + j * 32 + r - cbase;
#pragma unroll
            for (int reg = 0; reg < 16; ++reg) {
              const int row = m0 + wm * 64 + i * 32 + crow(reg, h);
              const int b = row >> 8, t = row & 255;
              size_t off;
              if (wide) off = ((size_t)((b * 2 + l) * 4 + (c >> 7)) * 256 + t) * 128 + (c & 127);
              else off = ((size_t)((b * 2 + l) * 8 + (c >> 6)) * 256 + t) * 64 + (c & 63);
              __builtin_nontemporal_store(acc[i][j][reg], &o[off]);
            }
          }
      }
    }
  }
}

DI void gdn_load_raw(const bf16_t* P, int row0, int T, int tlo, int h, int dir, int dvs, int tid, u32x4 (&ra)[8], u32x4 (&rv)[5], float& raa, float& rab) {
  const int cA = tid & 31, tgA = tid >> 5;
  const int pcolA = cA < 16 ? h * 128 + cA * 8 : 512 + h * 128 + (cA - 16) * 8;
  const u32x4 z = {0u, 0u, 0u, 0u};
#pragma unroll
  for (int rr = 0; rr < 8; ++rr) {
    const int tt = tlo + tgA * 4 + rr - 2;
    ra[rr] = (tt >= 0 && tt < T) ? *(const u32x4*)(P + (size_t)(row0 + tt) * PS + pcolA) : z;
  }
  {
    const int cB = tid & 7, tB = tid >> 3;
    const int pcolB = 1024 + h * 128 + dvs * 64 + cB * 8;
#pragma unroll
    for (int j = 0; j < 5; ++j) {
      const int tt = tlo + tB + j - 2;
      rv[j] = (tt >= 0 && tt < T) ? *(const u32x4*)(P + (size_t)(row0 + tt) * PS + pcolB) : z;
    }
  }
  if (tid < 32) {
    raa = bf2f(P[(size_t)(row0 + tlo + tid) * PS + C_AA + dir * 4 + h]);
    rab = bf2f(P[(size_t)(row0 + tlo + tid) * PS + C_AB + dir * 4 + h]);
  }
}

DI void gdn_step(f32x2 (&S)[2][8], const f32x2 (&kv)[8], const f32x2 (&qv)[8], const float* scp, const float* vp, float* obp, bool wr) {
  const f32x2 sc = *(const f32x2*)scp;
  const f32x2 v = *(const f32x2*)vp;
  f32x2 pk0[2], pk1[2];
#pragma unroll
  for (int c = 0; c < 2; ++c) { pk0[c] = (f32x2){0.f, 0.f}; pk1[c] = pk0[c]; }
#pragma unroll
  for (int i = 0; i < 4; ++i)
#pragma unroll
    for (int c = 0; c < 2; ++c) { pk0[c] = S[c][2 * i] * kv[2 * i] + pk0[c]; pk1[c] = S[c][2 * i + 1] * kv[2 * i + 1] + pk1[c]; }
  const float a = sc.x;
  const f32x2 a2 = {a, a};
#pragma unroll
  for (int c = 0; c < 2; ++c) {
    const float pk = red8((pk0[c].x + pk0[c].y) + (pk1[c].x + pk1[c].y));
    const float vn = sc.y * ((c ? v.y : v.x) - a * pk);
    const f32x2 vn2 = {vn, vn};
#pragma unroll
    for (int i = 0; i < 8; ++i) { S[c][i] = S[c][i] * a2; S[c][i] = kv[i] * vn2 + S[c][i]; }
  }
  float o[2];
#pragma unroll
  for (int c = 0; c < 2; ++c) {
    f32x2 pq0 = {0.f, 0.f}, pq1 = {0.f, 0.f};
#pragma unroll
    for (int i = 0; i < 4; ++i) { pq0 = S[c][2 * i] * qv[2 * i] + pq0; pq1 = S[c][2 * i + 1] * qv[2 * i + 1] + pq1; }
    o[c] = red8((pq0.x + pq0.y) + (pq1.x + pq1.y));
  }
  if (wr) *(f32x2*)obp = (f32x2){o[0], o[1]};
}

DI void gdn_item(const Params& p, int l, bool lat, int b, int h, int dir, int dvs, char* smem) {
  if (lat) __builtin_amdgcn_s_setprio(3); else __builtin_amdgcn_s_setprio(2);
  const int tid = get_tid(), lane = tid & 63, w = tid >> 6, dkg = lane & 7, cp = lane >> 3;
  const int T = lat ? 1024 : 256;
  const int row0 = lat ? NCTX + b * 1024 : b * 256;
  float* qs = (float*)smem;
  float* ks = qs + 32 * 128;
  float* vs = ks + 32 * 128;
  float* ob = vs + 32 * 64;
  float* sc4 = ob + 32 * 64;
  float* wc = sc4 + 32 * 4;
  const bf16_t* P = (const bf16_t*)(p.ws + OFF_P);
  __syncthreads();
  for (int i = tid; i < 320 * 5; i += 256) {
    const int ci = i / 5, j = i % 5;
    const int ch = ci < 128 ? h * 128 + ci : (ci < 256 ? 512 + h * 128 + ci - 128 : 1024 + h * 128 + dvs * 64 + ci - 256);
    wc[j * 320 + ci] = p.gdn_conv_w[((size_t)l * 1536 + ch) * 5 + j];
  }
  f32x2 S[2][8];
  const int dv0 = dvs * 64 + w * 16 + cp * 2;
  if (lat) {
    const float* s0 = p.state_gdn + ((size_t)(((b * 2 + l) * 2 + dir) * 4 + h)) * 16384;
#pragma unroll
    for (int c = 0; c < 2; ++c)
#pragma unroll
      for (int i = 0; i < 8; ++i) S[c][i] = (f32x2){s0[(dkg * 16 + 2 * i) * 128 + dv0 + c], s0[(dkg * 16 + 2 * i + 1) * 128 + dv0 + c]};
  } else {
#pragma unroll
    for (int c = 0; c < 2; ++c)
#pragma unroll
      for (int i = 0; i < 8; ++i) S[c][i] = (f32x2){0.f, 0.f};
  }
  const float Acoef = -expf(p.gdn_A_log[(l * 2 + dir) * 4 + h]);
  const float dtb = p.gdn_dt_bias[(l * 2 + dir) * 4 + h];
  bf16_t* OD = (bf16_t*)(p.ws + OFF_OD) + (size_t)(0 * 2 + dir) * NTOK * 512;
  u32x4 ra[8], rv[5];
  float raa = 0.f, rab = 0.f;
  const int nb = T / 32;
  gdn_load_raw(P, row0, T, dir ? T - 32 : 0, h, dir, dvs, tid, ra, rv, raa, rab);
  __syncthreads();
  for (int bi = 0; bi < nb; ++bi) {
    const int tlo = dir ? T - 32 - bi * 32 : bi * 32;
    {
      const int cA = tid & 31, tgA = tid >> 5, ci0 = cA * 8;
      float acc[4][8];
#pragma unroll
      for (int o = 0; o < 4; ++o)
#pragma unroll
        for (int e = 0; e < 8; ++e) acc[o][e] = 0.f;
#pragma unroll
      for (int rr = 0; rr < 8; ++rr) {
        float x[8];
        unpack8(ra[rr], x);
#pragma unroll
        for (int o = 0; o < 4; ++o) {
          const int j = rr - o;
          if (j >= 0 && j <= 4) {
#pragma unroll
            for (int e = 0; e < 8; ++e) acc[o][e] += x[e] * wc[j * 320 + ci0 + e];
          }
        }
      }
#pragma unroll
      for (int o = 0; o < 4; ++o) {
        const int tok = tgA * 4 + o;
        float* dst = cA < 16 ? qs + tok * 128 + cA * 8 : ks + tok * 128 + (cA - 16) * 8;
        float y[8];
        float ss = 0.f;
#pragma unroll
        for (int e = 0; e < 8; ++e) { y[e] = siluf_(acc[o][e]); ss += y[e] * y[e]; }
        ss = red8(ss); ss += dpp_mov<0x140>(ss);
        const float sc_ = rsqrtf(ss + 1e-6f) * (cA < 16 ? 0.08838834764831845f : 1.f);
        *(f32x4*)dst = (f32x4){y[0] * sc_, y[1] * sc_, y[2] * sc_, y[3] * sc_};
        *(f32x4*)(dst + 4) = (f32x4){y[4] * sc_, y[5] * sc_, y[6] * sc_, y[7] * sc_};
      }
    }
    {
      const int cB = tid & 7, tB = tid >> 3, ci0 = 256 + cB * 8;
      float acc[8];
#pragma unroll
      for (int e = 0; e < 8; ++e) acc[e] = 0.f;
#pragma unroll
      for (int j = 0; j < 5; ++j) {
        float x[8];
        unpack8(rv[j], x);
#pragma unroll
        for (int e = 0; e < 8; ++e) acc[e] += x[e] * wc[j * 320 + ci0 + e];
      }
      float* dst = vs + tB * 64 + cB * 8;
      f32x4 y0 = {siluf_(acc[0]), siluf_(acc[1]), siluf_(acc[2]), siluf_(acc[3])};
      f32x4 y1 = {siluf_(acc[4]), siluf_(acc[5]), siluf_(acc[6]), siluf_(acc[7])};
      *(f32x4*)dst = y0; *(f32x4*)(dst + 4) = y1;
    }
    if (tid < 32) {
      const float x = raa + dtb;
      const float sp = x > 20.f ? x : log1pf(expf(x));
      sc4[tid * 4 + 0] = expf(Acoef * sp);
      sc4[tid * 4 + 1] = sigmoidf_(rab);
    }
    __syncthreads();
    if (bi + 1 < nb) gdn_load_raw(P, row0, T, dir ? T - 64 - bi * 32 : (bi + 1) * 32, h, dir, dvs, tid, ra, rv, raa, rab);
    {
      f32x2 kvA[8], kvB[8], qvA[8], qvB[8];
      int tok = dir ? 31 : 0;
      const int dt = dir ? -1 : 1;
      const int vo = w * 16 + cp * 2;
      ld16(ks + tok * 128 + dkg * 16, kvA); ld16(qs + tok * 128 + dkg * 16, qvA);
#pragma unroll 1
      for (int s = 0; s < 32; s += 2) {
        {
          const int tn = tok + dt;
          ld16(ks + tn * 128 + dkg * 16, kvB); ld16(qs + tn * 128 + dkg * 16, qvB);
          gdn_step(S, kvA, qvA, sc4 + tok * 4, vs + tok * 64 + vo, ob + tok * 64 + vo, dkg == 0);
          tok = tn;
        }
        {
          const int tn = tok + dt;
          if (s + 2 < 32) { ld16(ks + tn * 128 + dkg * 16, kvA); ld16(qs + tn * 128 + dkg * 16, qvA); }
          gdn_step(S, kvB, qvB, sc4 + tok * 4, vs + tok * 64 + vo, ob + tok * 64 + vo, dkg == 0);
          tok = tn;
        }
      }
    }
    __syncthreads();
    {
      const int tok = tid >> 3, c8 = (tid & 7) * 8;
      *(u32x4*)(OD + (size_t)(row0 + tlo + tok) * 512 + h * 128 + dvs * 64 + c8) = pack8(ob + tok * 64 + c8);
    }
  }
  if (!lat) {
    float* so = p.out + O_SGDN + ((size_t)(((b * 2 + l) * 2 + dir) * 4 + h)) * 16384;
#pragma unroll
    for (int c = 0; c < 2; ++c)
#pragma unroll
      for (int i = 0; i < 8; ++i) { so[(dkg * 16 + 2 * i) * 128 + dv0 + c] = S[c][i].x; so[(dkg * 16 + 2 * i + 1) * 128 + dv0 + c] = S[c][i].y; }
  }
  __builtin_amdgcn_s_setprio(0);
}

DI void hgrn_load_raw(const bf16_t* P, int row0, int tlo, int h, int dir, int dvs, int tid, u32x4 (&rh)[5]) {
#pragma unroll
  for (int j = 0; j < 5; ++j) {
    const int u = tid + j * 256;
    if (u < 512) { const int tok = u >> 4, ch = u & 15; rh[j] = *(const u32x4*)(P + (size_t)(row0 + tlo + tok) * PS + C_CF + dir * 512 + h * 128 + ch * 8); }
    else if (u < 1024) { const int uu = u - 512, tok = uu >> 4, ch = uu & 15; rh[j] = *(const u32x4*)(P + (size_t)(row0 + tlo + tok) * PS + C_CQ + h * 128 + ch * 8); }
    else { const int uu = u - 1024, tok = uu >> 3, ch = uu & 7; rh[j] = *(const u32x4*)(P + (size_t)(row0 + tlo + tok) * PS + C_CI + h * 128 + dvs * 64 + ch * 8); }
  }
}
DI void hgrn_step(f32x2 (&D)[2][8], const f32x2 (&fv)[8], const f32x2 (&qv)[8], const f32x2 vcur, const f32x2 vnext, const float qsum, float* obp, bool wr) {
  float o[2];
#pragma unroll
  for (int c = 0; c < 2; ++c) {
    const float dvc = c ? vcur.y - vnext.y : vcur.x - vnext.x;
    const f32x2 dv2 = {dvc, dvc};
    f32x2 po0 = {0.f, 0.f}, po1 = {0.f, 0.f};
#pragma unroll
    for (int i = 0; i < 4; ++i) {
      D[c][2 * i] = fv[2 * i] * D[c][2 * i] + dv2; po0 = D[c][2 * i] * qv[2 * i] + po0;
      D[c][2 * i + 1] = fv[2 * i + 1] * D[c][2 * i + 1] + dv2; po1 = D[c][2 * i + 1] * qv[2 * i + 1] + po1;
    }
    o[c] = red8((po0.x + po0.y) + (po1.x + po1.y)) + (c ? vnext.y : vnext.x) * qsum;
  }
  if (wr) *(f32x2*)obp = (f32x2){o[0], o[1]};
}
DI void hgrn_item(const Params& p, int l, bool lat, int b, int h, int dir, int dvs, char* smem) {
  if (lat) __builtin_amdgcn_s_setprio(3); else __builtin_amdgcn_s_setprio(2);
  const int tid = get_tid(), lane = tid & 63, w = tid >> 6, dkg = lane & 7, cp = lane >> 3;
  const int T = lat ? 1024 : 256;
  const int row0 = lat ? NCTX + b * 1024 : b * 256;
  float* fs = (float*)smem;
  float* qs = fs + 32 * 128;
  float* vs = qs + 32 * 128;
  float* ob = vs + 32 * 64;
  float* qsum = ob + 32 * 64;
  const bf16_t* P = (const bf16_t*)(p.ws + OFF_P);
  const float* LB = (const float*)(p.ws + OFF_LB) + (l * 2 + dir) * 512 + h * 128;
  f32x2 S[2][8];
  const int dv0 = dvs * 64 + w * 16 + cp * 2;
  if (lat) {
    const float* s0 = p.state_hgrn + ((size_t)(((b * 2 + l) * 2 + dir) * 4 + h)) * 16384;
#pragma unroll
    for (int c = 0; c < 2; ++c)
#pragma unroll
      for (int i = 0; i < 8; ++i) S[c][i] = (f32x2){s0[(dkg * 16 + 2 * i) * 128 + dv0 + c], s0[(dkg * 16 + 2 * i + 1) * 128 + dv0 + c]};
  } else {
#pragma unroll
    for (int c = 0; c < 2; ++c)
#pragma unroll
      for (int i = 0; i < 8; ++i) S[c][i] = (f32x2){0.f, 0.f};
  }
  bf16_t* OD = (bf16_t*)(p.ws + OFF_OD) + (size_t)(1 * 2 + dir) * NTOK * 512;
  u32x4 rh[5];
  const int nb = T / 32;
  hgrn_load_raw(P, row0, dir ? T - 32 : 0, h, dir, dvs, tid, rh);
  for (int bi = 0; bi < nb; ++bi) {
    const int tlo = dir ? T - 32 - bi * 32 : bi * 32;
    __syncthreads();
#pragma unroll
    for (int j = 0; j < 5; ++j) {
      const int u = tid + j * 256;
      float x[8];
      unpack8(rh[j], x);
      if (u < 512) {
        const int tok = u >> 4, ch = u & 15;
        float y[8];
#pragma unroll
        for (int e = 0; e < 8; ++e) { const float lb = LB[ch * 8 + e]; y[e] = fmaxf(lb + (1.f - lb) * sigmoidf_(x[e]), 1e-30f); }
        *(f32x4*)(fs + tok * 128 + ch * 8) = (f32x4){y[0], y[1], y[2], y[3]}; *(f32x4*)(fs + tok * 128 + ch * 8 + 4) = (f32x4){y[4], y[5], y[6], y[7]};
      } else if (u < 1024) {
        const int uu = u - 512, tok = uu >> 4, ch = uu & 15;
        float y[8];
#pragma unroll
        for (int e = 0; e < 8; ++e) y[e] = siluf_(x[e]);
        *(f32x4*)(qs + tok * 128 + ch * 8) = (f32x4){y[0], y[1], y[2], y[3]};
        *(f32x4*)(qs + tok * 128 + ch * 8 + 4) = (f32x4){y[4], y[5], y[6], y[7]};
        float ps = ((y[0] + y[1]) + (y[2] + y[3])) + ((y[4] + y[5]) + (y[6] + y[7]));
        ps = red8(ps); ps += dpp_mov<0x140>(ps);
        if (ch == 0) qsum[tok] = ps;
      } else {
        const int uu = u - 1024, tok = uu >> 3, ch = uu & 7;
        *(f32x4*)(vs + tok * 64 + ch * 8) = (f32x4){x[0], x[1], x[2], x[3]}; *(f32x4*)(vs + tok * 64 + ch * 8 + 4) = (f32x4){x[4], x[5], x[6], x[7]};
      }
    }
    __syncthreads();
    if (bi + 1 < nb) hgrn_load_raw(P, row0, dir ? T - 64 - bi * 32 : (bi + 1) * 32, h, dir, dvs, tid, rh);
    {
      f32x2 fvA[8], qvA[8], fvB[8], qvB[8];
      f32x2 vA, vB;
      float qsA, qsB;
      int tok = dir ? 31 : 0;
      const int dt = dir ? -1 : 1;
      const int vo = w * 16 + cp * 2;
      ld16(fs + tok * 128 + dkg * 16, fvA); ld16(qs + tok * 128 + dkg * 16, qvA); vA = *(const f32x2*)(vs + tok * 64 + vo); qsA = qsum[tok];
#pragma unroll
      for (int c = 0; c < 2; ++c) {
        const float vc = c ? vA.y : vA.x;
        const f32x2 v2 = {vc, vc};
#pragma unroll
        for (int i = 0; i < 8; ++i) S[c][i] = S[c][i] - v2;
      }
#pragma unroll 1
      for (int s = 0; s < 32; s += 2) {
        {
          const int tn = tok + dt;
          ld16(fs + tn * 128 + dkg * 16, fvB); ld16(qs + tn * 128 + dkg * 16, qvB); vB = *(const f32x2*)(vs + tn * 64 + vo); qsB = qsum[tn];
          hgrn_step(S, fvA, qvA, vA, vB, qsA, ob + tok * 64 + vo, dkg == 0);
          tok = tn;
        }
        {
          const int tn = tok + dt;
          vA = (f32x2){0.f, 0.f};
          if (s + 2 < 32) { ld16(fs + tn * 128 + dkg * 16, fvA); ld16(qs + tn * 128 + dkg * 16, qvA); vA = *(const f32x2*)(vs + tn * 64 + vo); qsA = qsum[tn]; }
          hgrn_step(S, fvB, qvB, vB, vA, qsB, ob + tok * 64 + vo, dkg == 0);
          tok = tn;
        }
      }
    }
    __syncthreads();
    {
      const int tok = tid >> 3, c8 = (tid & 7) * 8;
      *(u32x4*)(OD + (size_t)(row0 + tlo + tok) * 512 + h * 128 + dvs * 64 + c8) = pack8(ob + tok * 64 + c8);
    }
  }
  if (!lat) {
    float* so = p.out + O_SHGRN + ((size_t)(((b * 2 + l) * 2 + dir) * 4 + h)) * 16384;
#pragma unroll
    for (int c = 0; c < 2; ++c)
#pragma unroll
      for (int i = 0; i < 8; ++i) { so[(dkg * 16 + 2 * i) * 128 + dv0 + c] = S[c][i].x; so[(dkg * 16 + 2 * i + 1) * 128 + dv0 + c] = S[c][i].y; }
  }
  __builtin_amdgcn_s_setprio(0);
}

struct AttnDesc {
  int ntiles, nctx, newkey0, rope;
  const float* ck; int ckstride;
  const bf16_t* vtc;
  const bf16_t* pk;
  const bf16_t* vtn; int vtn_stride;
};

template <int DV, bool NA>
DI void attn_pass(const Params& p, const AttnDesc& d, const bf16x8 (&qf)[4], f32x16 (&oacc)[DV / 32], float& lsum_out, char* smem, int qrow, int qcol) {
  const int tid = get_tid(), lane = tid & 63, r = lane & 31, h = lane >> 5;
  bf16_t* Ks = (bf16_t*)smem;
  bf16_t* Vs = Ks + 64 * 72;
  const float* rp = (const float*)(smem + 27648);
  const float* rc = (const float*)(p.ws + OFF_ROPE);
  const float* rs = rc + 1024 * 32;
  float m = -1e30f, lsum = 0.f;
#pragma unroll
  for (int i = 0; i < DV / 32; ++i)
#pragma unroll
    for (int q = 0; q < 16; ++q) oacc[i][q] = 0.f;
  const int myr0 = NA ? min(max(qrow - 4, 0), 8) : 0;
  const int myc0 = NA ? min(max(qcol - 8, 0), 48) : 0;
  for (int ti = 0; ti < d.ntiles; ++ti) {
    __syncthreads();
    {
      const int key = tid >> 2, c = tid & 3;
      float x1[8], x2[8];
      if (ti < d.nctx) {
        const float* src = d.ck + (size_t)(ti * 64 + key) * d.ckstride;
        const f32x4 a0 = *(const f32x4*)(src + 8 * c), a1 = *(const f32x4*)(src + 8 * c + 4);
        const f32x4 b0 = *(const f32x4*)(src + 32 + 8 * c), b1 = *(const f32x4*)(src + 32 + 8 * c + 4);
        x1[0] = a0.x; x1[1] = a0.y; x1[2] = a0.z; x1[3] = a0.w; x1[4] = a1.x; x1[5] = a1.y; x1[6] = a1.z; x1[7] = a1.w;
        x2[0] = b0.x; x2[1] = b0.y; x2[2] = b0.z; x2[3] = b0.w; x2[4] = b1.x; x2[5] = b1.y; x2[6] = b1.z; x2[7] = b1.w;
      } else {
        const int kk = d.newkey0 + (ti - d.nctx) * 64 + key;
        const bf16_t* src = d.pk + (size_t)kk * PS;
        const u32x4 a = *(const u32x4*)(src + 8 * c), bb = *(const u32x4*)(src + 32 + 8 * c);
        unpack8(a, x1); unpack8(bb, x2);
        if (d.rope) {
#pragma unroll
          for (int e = 0; e < 8; ++e) {
            const float cs = rc[kk * 32 + 8 * c + e], sn = rs[kk * 32 + 8 * c + e];
            const float y1 = x1[e] * cs - x2[e] * sn, y2 = x2[e] * cs + x1[e] * sn;
            x1[e] = y1; x2[e] = y2;
          }
        }
      }
      *(u32x4*)(Ks + key * 72 + 8 * c) = pack8(x1);
      *(u32x4*)(Ks + key * 72 + 32 + 8 * c) = pack8(x2);
    }
#pragma unroll
    for (int u = tid; u < DV * 8; u += 256) {
      const int dv = u >> 3, ch = u & 7;
      const bf16_t* src = ti < d.nctx ? d.vtc + (size_t)dv * 512 + ti * 64 + ch * 8
                                      : d.vtn + (size_t)dv * d.vtn_stride + d.newkey0 + (ti - d.nctx) * 64 + ch * 8;
      *(u32x4*)(Vs + dv * 72 + ch * 8) = *(const u32x4*)src;
    }
    __syncthreads();
    f32x16 st[2];
#pragma unroll
    for (int kb = 0; kb < 2; ++kb) {
#pragma unroll
      for (int q = 0; q < 16; ++q) st[kb][q] = 0.f;
#pragma unroll
      for (int ks = 0; ks < 4; ++ks) {
        const bf16x8 a = *(const bf16x8*)(Ks + (kb * 32 + r) * 72 + ks * 16 + h * 8);
        st[kb] = MFMA32(a, qf[ks], st[kb]);
      }
    }
    if (NA && ti >= d.nctx) {
      const int kr = d.newkey0 / 64 + (ti - d.nctx);
      const bool rowok = (kr >= myr0) && (kr < myr0 + 8);
      const int dr = min(max(kr - qrow + 7, 0), 14);
#pragma unroll
      for (int kb = 0; kb < 2; ++kb)
#pragma unroll
        for (int reg = 0; reg < 16; ++reg) {
          const int kc = kb * 32 + crow(reg, h);
          const bool ok = rowok && (kc >= myc0) && (kc < myc0 + 16);
          const int dc = min(max(kc - qcol + 15, 0), 30);
          st[kb][reg] = ok ? st[kb][reg] + rp[dr * 31 + dc] : -1e30f;
        }
    }
    float mx = -1e30f;
#pragma unroll
    for (int kb = 0; kb < 2; ++kb)
#pragma unroll
      for (int reg = 0; reg < 16; ++reg) mx = fmaxf(mx, st[kb][reg]);
    mx = fmaxf(mx, __shfl_xor(mx, 32));
    const float mnew = fmaxf(m, mx);
    const float alpha = __expf(m - mnew);
    m = mnew;
    float psum = 0.f;
#pragma unroll
    for (int kb = 0; kb < 2; ++kb)
#pragma unroll
      for (int reg = 0; reg < 16; ++reg) { const float e = __expf(st[kb][reg] - mnew); st[kb][reg] = e; psum += e; }
    psum += __shfl_xor(psum, 32);
    lsum = lsum * alpha + psum;
    if (__any(alpha != 1.f)) {
#pragma unroll
      for (int i = 0; i < DV / 32; ++i)
#pragma unroll
        for (int q = 0; q < 16; ++q) oacc[i][q] *= alpha;
    }
#pragma unroll
    for (int kb = 0; kb < 2; ++kb)
#pragma unroll
      for (int s = 0; s < 2; ++s) {
        u32x4 pu;
        pu.x = pack2(st[kb][8 * s + 0], st[kb][8 * s + 1]); pu.y = pack2(st[kb][8 * s + 2], st[kb][8 * s + 3]);
        pu.z = pack2(st[kb][8 * s + 4], st[kb][8 * s + 5]); pu.w = pack2(st[kb][8 * s + 6], st[kb][8 * s + 7]);
        const bf16x8 pf = __builtin_bit_cast(bf16x8, pu);
#pragma unroll
        for (int dvb = 0; dvb < DV / 32; ++dvb) {
          const bf16_t* vrow = Vs + (dvb * 32 + r) * 72 + kb * 32 + 16 * s + 4 * h;
          const s16x4 lo = *(const s16x4*)(vrow), hi = *(const s16x4*)(vrow + 8);
          const bf16x8 a2 = __builtin_shufflevector(lo, hi, 0, 1, 2, 3, 4, 5, 6, 7);
          oacc[dvb] = MFMA32(a2, pf, oacc[dvb]);
        }
      }
  }
  lsum_out = lsum;
}

DI void diff_item(const Params& p, int l, bool lat, int b, int h, int qt, char* smem, int dry) {
  const int tid = get_tid(), lane = tid & 63, w = tid >> 6, r = lane & 31, hh = lane >> 5;
  bf16_t* P = (bf16_t*)(p.ws + OFF_P);
  const int T = lat ? 1024 : 256, row0 = lat ? NCTX + b * 1024 : b * 256;
  const int pos = qt * 128 + w * 32 + r;
  const size_t rowq = (size_t)(row0 + pos);
  const float* rc = (const float*)(p.ws + OFF_ROPE);
  const float* rs = rc + 1024 * 32;
  unsigned* stash = (unsigned*)(smem + 29696);
  f32x16 res[4];
#pragma unroll 1
  for (int mm = 0; mm < 2; ++mm) {
    float q[4][8];
#pragma unroll
    for (int ks = 0; ks < 4; ++ks) { const u32x4 v = *(const u32x4*)(P + rowq * PS + C_BQ + h * 128 + mm * 64 + ks * 16 + hh * 8); unpack8(v, q[ks]); }
    if (lat) {
#pragma unroll
      for (int ks = 0; ks < 2; ++ks)
#pragma unroll
        for (int e = 0; e < 8; ++e) {
          const int pi = ks * 16 + hh * 8 + e;
          const float cs = rc[pos * 32 + pi], sn = rs[pos * 32 + pi];
          const float x1 = q[ks][e], x2 = q[ks + 2][e];
          q[ks][e] = x1 * cs - x2 * sn; q[ks + 2][e] = x2 * cs + x1 * sn;
        }
    }
    bf16x8 qf[4];
#pragma unroll
    for (int ks = 0; ks < 4; ++ks) {
#pragma unroll
      for (int e = 0; e < 8; ++e) q[ks][e] *= 0.125f;
      qf[ks] = __builtin_bit_cast(bf16x8, pack8(q[ks]));
    }
    AttnDesc d;
    if (lat) {
      d.ntiles = 24; d.nctx = 8; d.newkey0 = 0; d.rope = 1;
      d.ck = p.cache_diff_k + ((size_t)((b * 2 + l) * 4 + h) * 512) * 128 + mm * 64; d.ckstride = 128;
      d.vtc = (const bf16_t*)(p.ws + OFF_VTCB) + (size_t)(b * 4 + h) * 128 * 512;
      d.pk = P + (size_t)row0 * PS + C_BK + h * 128 + mm * 64;
      d.vtn = (const bf16_t*)(p.ws + OFF_VTB) + (size_t)2097152 + ((size_t)b * 512 + h * 128) * 1024; d.vtn_stride = 1024;
    } else {
      d.ntiles = 4; d.nctx = 0; d.newkey0 = 0; d.rope = 0;
      d.ck = nullptr; d.ckstride = 0; d.vtc = nullptr;
      d.pk = P + (size_t)row0 * PS + C_BK + h * 128 + mm * 64;
      d.vtn = (const bf16_t*)(p.ws + OFF_VTB) + ((size_t)b * 512 + h * 128) * 256; d.vtn_stride = 256;
    }
    f32x16 oacc[4];
    float lsum;
    attn_pass<128, false>(p, d, qf, oacc, lsum, smem, 0, 0);
    const float coef = (mm == 0 ? 1.f : -((const float*)(p.ws + OFF_CTR))[16 + l]) / lsum;
    if (mm == 0) {
#pragma unroll
      for (int i = 0; i < 4; ++i)
#pragma unroll
        for (int q2 = 0; q2 < 8; ++q2) stash[(i * 8 + q2) * 256 + tid] = pack2(coef * oacc[i][2 * q2], coef * oacc[i][2 * q2 + 1]);
    } else {
#pragma unroll
      for (int i = 0; i < 4; ++i)
#pragma unroll
        for (int q2 = 0; q2 < 8; ++q2) {
          const unsigned u = stash[(i * 8 + q2) * 256 + tid];
          res[i][2 * q2] = lo2f(u) + coef * oacc[i][2 * q2];
          res[i][2 * q2 + 1] = hi2f(u) + coef * oacc[i][2 * q2 + 1];
        }
    }
  }
  float ss = 0.f;
#pragma unroll
  for (int i = 0; i < 4; ++i)
#pragma unroll
    for (int q2 = 0; q2 < 16; ++q2) ss += res[i][q2] * res[i][q2];
  ss += __shfl_xor(ss, 32);
  const float rstd = rsqrtf(ss * (1.f / 128.f) + 1e-6f) * ((const float*)(p.ws + OFF_CTR))[18 + l];
  const float* g = p.diff_norm_g + l * 128;
#pragma unroll
  for (int i = 0; i < 4; ++i)
#pragma unroll
    for (int gq = 0; gq < 4; ++gq) {
      const int dv = i * 32 + 8 * gq + 4 * hh;
      u32x2 v;
      v.x = pack2(res[i][4 * gq] * rstd * g[dv], res[i][4 * gq + 1] * rstd * g[dv + 1]);
      v.y = pack2(res[i][4 * gq + 2] * rstd * g[dv + 2], res[i][4 * gq + 3] * rstd * g[dv + 3]);
      if (!dry) *(u32x2*)(P + rowq * PS + C_BQ + h * 128 + dv) = v;
    }
}

DI void na_item(const Params& p, int l, bool lat, int b, int h, int idx, char* smem, int dry) {
  const int tid = get_tid(), lane = tid & 63, w = tid >> 6, r = lane & 31, hh = lane >> 5;
  bf16_t* P = (bf16_t*)(p.ws + OFF_P);
  const int row0 = lat ? NCTX + b * 1024 : b * 256;
  int qrow = 0, qcol = 0, pos;
  if (lat) { qrow = idx * 2 + (w >> 1); qcol = (w & 1) * 32 + r; pos = qrow * 64 + qcol; }
  else pos = idx * 128 + w * 32 + r;
  const size_t rowq = (size_t)(row0 + pos);
  float q[4][8];
  bf16x8 qf[4];
#pragma unroll
  for (int ks = 0; ks < 4; ++ks) {
    const u32x4 v = *(const u32x4*)(P + rowq * PS + C_DQ + h * 64 + ks * 16 + hh * 8);
    unpack8(v, q[ks]);
#pragma unroll
    for (int e = 0; e < 8; ++e) q[ks][e] *= 0.125f;
    qf[ks] = __builtin_bit_cast(bf16x8, pack8(q[ks]));
  }
  AttnDesc d;
  f32x16 oacc[2];
  float lsum;
  if (lat) {
    const int rbase = idx * 2;
    const int rlo = min(max(rbase - 4, 0), 8), rhi = min(max(rbase + 1 - 4, 0), 8) + 7;
    __syncthreads();
    float* rp = (float*)(smem + 27648);
    for (int i = tid; i < 465; i += 256) rp[i] = p.na_rpb[((size_t)l * 8 + h) * 465 + i];
    d.ntiles = 8 + (rhi - rlo + 1); d.nctx = 8; d.newkey0 = rlo * 64; d.rope = 0;
    d.ck = p.cache_na_k + ((size_t)((b * 2 + l) * 8 + h) * 512) * 64; d.ckstride = 64;
    d.vtc = (const bf16_t*)(p.ws + OFF_VTCD) + (size_t)(b * 8 + h) * 64 * 512;
    d.pk = P + (size_t)row0 * PS + C_DK + h * 64;
    d.vtn = (const bf16_t*)(p.ws + OFF_VTD) + (size_t)2097152 + ((size_t)b * 512 + h * 64) * 1024; d.vtn_stride = 1024;
    attn_pass<64, true>(p, d, qf, oacc, lsum, smem, qrow, qcol);
  } else {
    d.ntiles = 4; d.nctx = 0; d.newkey0 = 0; d.rope = 0;
    d.ck = nullptr; d.ckstride = 0; d.vtc = nullptr;
    d.pk = P + (size_t)row0 * PS + C_DK + h * 64;
    d.vtn = (const bf16_t*)(p.ws + OFF_VTD) + ((size_t)b * 512 + h * 64) * 256; d.vtn_stride = 256;
    attn_pass<64, false>(p, d, qf, oacc, lsum, smem, 0, 0);
  }
  const float inv = 1.f / lsum;
#pragma unroll
  for (int i = 0; i < 2; ++i)
#pragma unroll
    for (int gq = 0; gq < 4; ++gq) {
      const int dv = i * 32 + 8 * gq + 4 * hh;
      u32x2 v;
      v.x = pack2(oacc[i][4 * gq] * inv, oacc[i][4 * gq + 1] * inv);
      v.y = pack2(oacc[i][4 * gq + 2] * inv, oacc[i][4 * gq + 3] * inv);
      if (!dry) *(u32x2*)(P + rowq * PS + C_DQ + h * 64 + dv) = v;
    }
}

DI void phase_mixers(const Params& p, int l, char* smem, int sel, int dry, int cidx) {
  __shared__ int s_item;
  __shared__ int s_q[4];
  if (threadIdx.x == 0) {
    const unsigned hw = (unsigned)__builtin_amdgcn_s_getreg((31 << 11) | 4);
    const unsigned key = ((xb_xcc_id() & 7u) << 8) | (((hw >> 13) & 7u) << 5) | (((hw >> 12) & 1u) << 4) | ((hw >> 8) & 15u);
    s_q[0] = (int)(atomicAdd((unsigned*)(p.ws + OFF_CUCTR) + cidx * 2048 + key, 1u) & 1u);
    s_q[1] = !(sel & 1); s_q[2] = !(sel & 2);
  }
  for (;;) {
    __syncthreads();
    if (threadIdx.x == 0) {
      unsigned* qc = (unsigned*)(p.ws + OFF_CTR) + 32 + cidx * 2;
      const int pref = s_q[0];
      int it = -1;
      for (int tr = 0; tr < 2 && it < 0; ++tr) {
        const int q = tr == 0 ? pref : 1 - pref;
        if (s_q[1 + q]) continue;
        const int v = (int)atomicAdd(qc + q, 1u);
        if (v < (q == 0 ? 768 : 1152)) it = q * 1024 + v;
        else s_q[1 + q] = 1;
      }
      s_item = it;
    }
    __syncthreads();
    const int item = s_item;
    if (item < 0) break;
    if (item < 128) { const int i = item; gdn_item(p, l, true, i >> 4, (i >> 2) & 3, (i >> 1) & 1, i & 1, smem); }
    else if (item < 256) { const int i = item - 128; hgrn_item(p, l, true, i >> 4, (i >> 2) & 3, (i >> 1) & 1, i & 1, smem); }
    else if (item < 512) { const int i = item - 256; gdn_item(p, l, false, i >> 4, (i >> 2) & 3, (i >> 1) & 1, i & 1, smem); }
    else if (item < 768) { const int i = item - 512; hgrn_item(p, l, false, i >> 4, (i >> 2) & 3, (i >> 1) & 1, i & 1, smem); }
    else if (item < 1024 + 256) { const int i = item - 1024; diff_item(p, l, true, i >> 5, (i >> 3) & 3, i & 7, smem, dry); }
    else if (item < 1024 + 768) { const int i = item - 1024 - 256; na_item(p, l, true, i >> 6, (i >> 3) & 7, i & 7, smem, dry); }
    else if (item < 1024 + 896) { const int i = item - 1024 - 768; diff_item(p, l, false, i >> 3, (i >> 1) & 3, i & 1, smem, dry); }
    else { const int i = item - 1024 - 896; na_item(p, l, false, i >> 4, (i >> 1) & 7, i & 1, smem, dry); }
  }
}

DI void phase_combine(const Params& p, int l, int dry) {
  const int tid = get_tid(), lane = tid & 63, w = tid >> 6;
  bf16_t* P = (bf16_t*)(p.ws + OFF_P);
  const bf16_t* OD = (const bf16_t*)(p.ws + OFF_OD);
  for (int it = blockIdx.x; it < NTOK * 2; it += gridDim.x) {
    const int wi = it * 4 + w;
    const int token = wi >> 3, mh = wi & 7, mixer = mh >> 2, h = mh & 3;
    const size_t o0 = ((size_t)(mixer * 2 + 0) * NTOK + token) * 512 + h * 128 + lane * 2;
    const size_t o1 = ((size_t)(mixer * 2 + 1) * NTOK + token) * 512 + h * 128 + lane * 2;
    const unsigned a = *(const unsigned*)(OD + o0), bq = *(const unsigned*)(OD + o1);
    const float v0 = lo2f(a) + lo2f(bq), v1 = hi2f(a) + hi2f(bq);
    float ss = v0 * v0 + v1 * v1;
    ss = wave_sum(ss);
    const float rstd = rsqrtf(ss * (1.f / 128.f) + 1e-6f);
    const float* g = (mixer ? p.hgrn_norm_g : p.gdn_norm_g) + l * 128 + lane * 2;
    bf16_t* zp = P + (size_t)token * PS + (mixer ? C_CG : C_AZ) + h * 128 + lane * 2;
    const unsigned z = *(const unsigned*)zp;
    const float y0 = v0 * rstd * g[0] * siluf_(lo2f(z)), y1 = v1 * rstd * g[1] * siluf_(hi2f(z));
    if (dry) zp = (bf16_t*)(p.ws + OFF_WTIN) + ((size_t)(wi & 0xfffff) * 8 + lane * 2 % 8);
    *(unsigned*)zp = pack2(y0, y1);
  }
}

template <int NJ>
DI void merge_tile(const Params& p, char* smem, int m0, int n0) {
  const int tid = get_tid(), lane = tid & 63, w = tid >> 6, wm = w >> 1, wn = w & 1, r = lane & 31, h = lane >> 5;
  const bf16_t* H = (const bf16_t*)(p.ws + OFF_H);
  const bf16_t* P = (const bf16_t*)(p.ws + OFF_P);
  const bf16_t* WTMG = (const bf16_t*)(p.ws + OFF_WTIN) + (size_t)7808 * 1024;
  const bf16_t* WTBR = (const bf16_t*)(p.ws + OFF_WTBR);
  bf16_t* M = (bf16_t*)(p.ws + OFF_M);
  f32x16 macc[2][NJ];
  zero_acc<2, NJ>(macc);
#pragma unroll 1
  for (int n = 0; n < 4; ++n) {
    unsigned gt[2][NJ][8];
    {
      f32x16 a1[2][NJ];
      zero_acc<2, NJ>(a1);
      gemm_kloop<2, NJ, 3>(a1, H + (size_t)m0 * 1024, 1024, WTMG + ((size_t)n * 1024 + n0) * 1024, 1024, 1024, (bf16_t*)smem);
#pragma unroll
      for (int i = 0; i < 2; ++i)
#pragma unroll
        for (int j = 0; j < NJ; ++j)
#pragma unroll
          for (int q = 0; q < 8; ++q) gt[i][j][q] = pack2(sigmoidf_(a1[i][j][2 * q]), sigmoidf_(a1[i][j][2 * q + 1]));
    }
    const int bcol = n == 0 ? C_AZ : (n == 1 ? C_BQ : (n == 2 ? C_CG : C_DQ));
    {
      f32x16 a2[2][NJ];
      zero_acc<2, NJ>(a2);
      gemm_kloop<2, NJ, 3>(a2, P + (size_t)m0 * PS + bcol, PS, WTBR + ((size_t)n * 1024 + n0) * 512, 512, 512, (bf16_t*)smem);
#pragma unroll
      for (int i = 0; i < 2; ++i)
#pragma unroll
        for (int j = 0; j < NJ; ++j)
#pragma unroll
          for (int q = 0; q < 8; ++q) {
            macc[i][j][2 * q] += lo2f(gt[i][j][q]) * a2[i][j][2 * q];
            macc[i][j][2 * q + 1] += hi2f(gt[i][j][q]) * a2[i][j][2 * q + 1];
          }
    }
  }
#pragma unroll
  for (int i = 0; i < 2; ++i)
#pragma unroll
    for (int j = 0; j < NJ; ++j) {
      store_blk_bf16(M, 1024, m0 + wm * 64 + i * 32, n0 + wn * 32 * NJ + j * 32 + r, macc[i][j], r, h);
    }
}
DI void phase_merge(const Params& p, int l, char* smem) {
  const int xcd = blockIdx.x & 7, local = blockIdx.x >> 3, nloc = gridDim.x >> 3;
  if (nloc == 64) {
    { const int w = local; merge_tile<2>(p, smem, (xcd * 12 + w % 12) * 128, (w / 12) * 128); }
    { const int w = 64 + (local >> 1); merge_tile<1>(p, smem, (xcd * 12 + w % 12) * 128, (w / 12) * 128 + (local & 1) * 64); }
  } else {
    int tm, tn;
    for (int it = 0; tile_map(it, 96, 16, tm, tn); ++it) merge_tile<1>(p, smem, tm * 128, tn * 64);
  }
}

template <int NJ>
DI void resid_tile(const Params& p, int l, int which, char* smem, int m0, int n0) {
  const int tid = get_tid(), lane = tid & 63, w = tid >> 6, wm = w >> 1, wn = w & 1, r = lane & 31, h = lane >> 5;
  const bf16_t* A = (const bf16_t*)(p.ws + (which ? OFF_G : OFF_M));
  const int K = which ? 2816 : 1024;
  const bf16_t* WT = (const bf16_t*)(p.ws + (which ? OFF_WTDN : OFF_WTOUT));
  const float* MOD = (const float*)(p.ws + OFF_MOD);
  float* X = p.out;
  const bool first = (l == 0 && which == 0);
  f32x16 acc[2][NJ];
  zero_acc<2, NJ>(acc);
  gemm_kloop<2, NJ, 3>(acc, A + (size_t)m0 * K, K, WT + (size_t)n0 * K, K, K, (bf16_t*)smem);
  const int cond = cond_of_row(m0);
#pragma unroll
  for (int j = 0; j < NJ; ++j) {
    const int col = n0 + wn * 32 * NJ + j * 32 + r;
    const float gate = MOD[((size_t)l * 9 + cond) * 6144 + (which ? 5120 : 2048) + col];
    const float gate_n = dpp_mov<0xB1>(gate);
    const bool odd = (r & 1) != 0;
    const int colbase = col & ~1;
#pragma unroll
    for (int i = 0; i < 2; ++i)
#pragma unroll
      for (int k = 0; k < 8; ++k) {
        const float lo = acc[i][j][k], hi = acc[i][j][k + 8];
        const float recv = dpp_mov<0xB1>(odd ? lo : hi);
        const int row = m0 + wm * 64 + i * 32 + crow(odd ? k + 8 : k, h);
        f32x2* xp = (f32x2*)(X + (size_t)row * 1024 + colbase);
        const f32x2* xr = first ? (const f32x2*)(row < NCTX ? p.x_prompt + (size_t)row * 1024 + colbase : p.x_sample + (size_t)(row - NCTX) * 1024 + colbase) : (const f32x2*)xp;
        const f32x2 xv = *xr;
        f32x2 o;
        o.x = xv.x + (odd ? gate_n * recv : gate * lo);
        o.y = xv.y + (odd ? gate * hi : gate_n * recv);
        *xp = o;
      }
  }
}
DI void phase_resid(const Params& p, int l, int which, char* smem, int dry) {
  const int xcd = blockIdx.x & 7, local = blockIdx.x >> 3, nloc = gridDim.x >> 3;
  if (nloc == 64) {
    { const int w = local; resid_tile<2>(p, l, which, smem, (xcd * 12 + w % 12) * 128, (w / 12) * 128); }
    { const int w = 64 + (local >> 1); resid_tile<1>(p, l, which, smem, (xcd * 12 + w % 12) * 128, (w / 12) * 128 + (local & 1) * 64); }
  } else {
    int tm, tn;
    for (int it = 0; tile_map(it, 96, 16, tm, tn); ++it) resid_tile<1>(p, l, which, smem, tm * 128, tn * 64);
  }
}

template <int MI, int MODE>
DI void gateup_tile(const Params& p, char* smem, int m0, int n0) {
  const int tid = get_tid(), lane = tid & 63, w = tid >> 6, wm = w >> 1, wn = w & 1, r = lane & 31, h = lane >> 5;
  const bf16_t* H = (const bf16_t*)(p.ws + OFF_H);
  const bf16_t* WT = (const bf16_t*)(p.ws + OFF_WTGU);
  bf16_t* G = (bf16_t*)(p.ws + OFF_G);
  f32x16 acc[MI][2];
  zero_acc<MI, 2>(acc);
  gemm_kloop<MI, 2, MODE>(acc, H + (size_t)m0 * 1024, 1024, WT + (size_t)n0 * 1024, 1024, 1024, (bf16_t*)smem);
  const int col = ((n0 + wn * 64) >> 6) * 32 + r;
#pragma unroll
  for (int i = 0; i < MI; ++i) {
    f32x16 g;
#pragma unroll
    for (int reg = 0; reg < 16; ++reg) g[reg] = siluf_(acc[i][0][reg]) * acc[i][1][reg];
    store_blk_bf16(G, 2816, m0 + wm * 32 * MI + i * 32, col, g, r, h);
  }
}
DI void phase_gateup(const Params& p, char* smem) {
  const int xcd = blockIdx.x & 7, local = blockIdx.x >> 3, nloc = gridDim.x >> 3;
  if (nloc == 64) {
#pragma unroll 1
    for (int it = 0; it < 8; ++it) { const int w = local + it * 64; gateup_tile<2, 3>(p, smem, (xcd * 12 + w % 12) * 128, (w / 12) * 128); }
    if (local < 32) { const int w = 512 + (local >> 1); gateup_tile<1, 3>(p, smem, (xcd * 12 + w % 12) * 128 + (local & 1) * 64, (w / 12) * 128); }
  } else {
    int tm, tn;
    for (int it = 0; tile_map(it, 96, 44, tm, tn); ++it) gateup_tile<2, 3>(p, smem, tm * 128, tn * 128);
  }
}

#define XB_TMO      128
#define XB_XCNT(j)  (256  + 64 * (j))
#define XB_XSUB(j)  (1280 + 64 * (j))
#define XB_XGEN(j)  (2304 + 64 * (j))
#define XB_TOP      3328
#define XB_TOPGEN   3392
#define XCD_BAR_WORDS 3456
#define XB_SPIN_CAP (1u << 18)
#define LAS __attribute__((address_space(3)))
DI unsigned xb_ld(unsigned* p) { return __hip_atomic_load(p, __ATOMIC_RELAXED, __HIP_MEMORY_SCOPE_AGENT); }
DI unsigned xb_add(unsigned* p, unsigned v) { return __hip_atomic_fetch_add(p, v, __ATOMIC_RELAXED, __HIP_MEMORY_SCOPE_AGENT); }
DI unsigned xb_xcc_id() { return (unsigned)__builtin_amdgcn_s_getreg((3 << 11) | 20) & 0xFu; }
#define XB_SPIN(cond, bar) do { unsigned _sp = 0; while (cond) { __builtin_amdgcn_s_sleep(1); \
    if ((++_sp & 255u) == 0u) { if (xb_ld(&(bar)[XB_TMO])) break; if (_sp > XB_SPIN_CAP) { atomicAdd(&(bar)[XB_TMO], 1u); break; } } } } while (0)
struct XcdBarrier { unsigned* bar; unsigned x; volatile LAS unsigned* st; };
DI XcdBarrier xcd_barrier_post(unsigned* bar, volatile LAS unsigned* st) {
  XcdBarrier b; b.bar = bar; b.x = xb_xcc_id(); b.st = st;
  if (threadIdx.x == 0) (void)xb_add(&bar[XB_XCNT(b.x)], 1u);
  return b;
}
DI void xcd_barrier_complete(unsigned* bar, unsigned x, unsigned& nloc, unsigned& nx) {
  const unsigned G = gridDim.x * gridDim.y * gridDim.z;
  unsigned sum, cnt, mine, sp = 0u;
  for (;;) {
    sum = 0u; cnt = 0u; mine = 0u;
#pragma unroll
    for (unsigned j = 0; j < 16; ++j) { const unsigned c = xb_ld(&bar[XB_XCNT(j)]); sum += c; cnt += (c > 0u) ? 1u : 0u; mine = (j == x) ? c : mine; }
    if (sum == G) break;
    __builtin_amdgcn_s_sleep(1);
    if ((++sp & 255u) == 0u) { if (xb_ld(&bar[XB_TMO])) break; if (sp > XB_SPIN_CAP) { atomicAdd(&bar[XB_TMO], 1u); break; } }
  }
  nloc = mine > 0u ? mine : 1u; nx = cnt > 0u ? cnt : 1u;
}
DI void xcd_barrier(const XcdBarrier& b) {
  asm volatile("s_waitcnt vmcnt(0)" ::: "memory");
  __syncthreads();
  if (threadIdx.x == 0) {
    unsigned* bar = b.bar;
    __builtin_amdgcn_s_waitcnt(0);
    unsigned nloc = b.st[0], nx = b.st[1];
    if (nloc == 0u) { xcd_barrier_complete(bar, b.x, nloc, nx); b.st[0] = nloc; b.st[1] = nx; }
    const unsigned old = xb_add(&bar[XB_XSUB(b.x)], 1u);
    const unsigned gen = old / nloc;
    if (old + 1u == (gen + 1u) * nloc) {
      __builtin_amdgcn_fence(__ATOMIC_RELEASE, "agent");
      asm volatile("s_waitcnt vmcnt(0)" ::: "memory");
      const unsigned og = xb_add(&bar[XB_TOP], 1u);
      const unsigned tg = og / nx;
      if (og + 1u == (tg + 1u) * nx) xb_add(&bar[XB_TOPGEN], 1u);
      else XB_SPIN(xb_ld(&bar[XB_TOPGEN]) == tg, bar);
      __builtin_amdgcn_fence(__ATOMIC_ACQUIRE, "agent");
      xb_add(&bar[XB_XGEN(b.x)], 1u);
      asm volatile("s_waitcnt vmcnt(0)" ::: "memory");
    } else {
      XB_SPIN(xb_ld(&bar[XB_XGEN(b.x)]) == gen, bar);
      __builtin_amdgcn_fence(__ATOMIC_ACQUIRE, "agent");
      asm volatile("s_waitcnt vmcnt(0)" ::: "memory");
    }
  }
  __syncthreads();
}

DI void run_phase(const Params& p, int ph, char* smem) {
  if (ph == 0) { phase_prologue(p, smem); phase_convert(p, 0, smem); return; }
  if (ph == NPH - 1) { phase_norm(p, 0, 2); return; }
  const int l = (ph - 1) / 9, s = (ph - 1) % 9;
  switch (s) {
    case 0: if (l > 0) phase_convert(p, l, smem); phase_norm(p, l, 0); break;
    case 1: phase_gemm_in(p, l, smem); break;
    case 2: phase_mixers(p, l, smem, 3, 0, l); break;
    case 3: phase_combine(p, l, 0); break;
    case 4: phase_merge(p, l, smem); break;
    case 5: phase_resid(p, l, 0, smem, 0); break;
    case 6: phase_norm(p, l, 1); break;
    case 7: phase_gateup(p, smem); break;
    default: phase_resid(p, l, 1, smem, 0); break;
  }
}

__global__ void __launch_bounds__(256, 2) hybrid_mega(Params p) {
  char* smem = dyn_smem;
  __shared__ uint4 xb_words;
  if (threadIdx.x == 0) xb_words = make_uint4(0u, 0u, 0u, 0u);
  __syncthreads();
  const XcdBarrier xb = xcd_barrier_post((unsigned*)(p.ws + OFF_BAR), (volatile LAS unsigned*)&xb_words);
  typedef const __attribute__((address_space(4))) Params* kparg_t;
  kparg_t kp = (kparg_t)__builtin_amdgcn_kernarg_segment_ptr();
  const int ph_lo = kp->ph_lo, ph_hi = kp->ph_hi, use_cg = kp->use_cg;
  for (int ph = ph_lo; ph < ph_hi; ++ph) {
    asm volatile("" : "+s"(kp));
    run_phase(*(const Params*)kp, ph, smem);
    if (ph + 1 < ph_hi) {
      if (use_cg) cg::this_grid().sync();
      else xcd_barrier(xb);
    }
  }
}

extern "C" void kernel_launch(void* const* d_in, const int* in_sizes, int n_in, void* d_out, int out_size, void* d_ws, size_t ws_size,
                              hipStream_t stream) {
  if (ws_size < WS_TOTAL || n_in < 30) { fprintf(stderr, "workspace too small: %zu < %zu\n", ws_size, (size_t)WS_TOTAL); return; }
  Params p{};
  const float** pp = (const float**)&p;
  for (int i = 0; i < 30; ++i) pp[i] = (const float*)d_in[i];
  p.out = (float*)d_out;
  p.ws = (char*)d_ws;
  static int grid_blocks = 0;
  if (!grid_blocks) {
    int dev = 0, cus = 0, per_cu = 0;
    hipGetDevice(&dev);
    hipDeviceGetAttribute(&cus, hipDeviceAttributeMultiprocessorCount, dev);
    hipFuncSetAttribute((const void*)hybrid_mega, hipFuncAttributeMaxDynamicSharedMemorySize, SMEM_BYTES);
    hipOccupancyMaxActiveBlocksPerMultiprocessor(&per_cu, hybrid_mega, 256, SMEM_BYTES);
    if (per_cu > 2) per_cu = 2;
    if (per_cu < 1) per_cu = 1;
    grid_blocks = (cus * per_cu) & ~7;
  }
  hipMemsetAsync((char*)d_ws + OFF_BAR, 0, 16384 + 65536, stream);
#if FUSED
#ifndef PROBE_MASK
#define PROBE_MASK 0
#endif
  p.ph_lo = 0; p.ph_hi = NPH; p.use_cg = 0; p.pad_ = PROBE_MASK;
  void* args[] = {&p};
  hipError_t e = hipLaunchCooperativeKernel((void*)hybrid_mega, dim3(grid_blocks), dim3(256), args, SMEM_BYTES, stream);
  if (e != hipSuccess) fprintf(stderr, "cooperative launch failed: %s (grid %d)\n", hipGetErrorString(e), grid_blocks);
#else
  for (int ph = 0; ph < NPH; ++ph) {
    p.ph_lo = ph; p.ph_hi = ph + 1;
    hipLaunchKernelGGL(hybrid_mega, dim3(grid_blocks), dim3(256), SMEM_BYTES, stream, p);
  }
#endif
}
#ifdef RESOURCE_PROBE
#define PROBE_K(name, body) __global__ void __launch_bounds__(256, 2) name(Params p) { char* smem = dyn_smem; body; }
PROBE_K(k_prologue, phase_prologue(p, smem))
PROBE_K(k_norm, phase_norm(p, p.ph_lo, p.ph_hi))
PROBE_K(k_convert, phase_convert(p, p.ph_lo, smem))
PROBE_K(k_gemm_in, phase_gemm_in(p, p.ph_lo, smem))
PROBE_K(k_gdn, gdn_item(p, p.ph_lo, p.ph_hi & 1, 1, 2, p.ph_hi & 2, 1, smem))
PROBE_K(k_hgrn, hgrn_item(p, p.ph_lo, p.ph_hi & 1, 1, 2, p.ph_hi & 2, 1, smem))
PROBE_K(k_diff, diff_item(p, p.ph_lo, p.ph_hi & 1, 1, 2, 3, smem, 0))
PROBE_K(k_na, na_item(p, p.ph_lo, p.ph_hi & 1, 1, 2, 3, smem, 0))
PROBE_K(k_combine, phase_combine(p, p.ph_lo, 0))
PROBE_K(k_merge, phase_merge(p, p.ph_lo, smem))
PROBE_K(k_resid, phase_resid(p, p.ph_lo, p.ph_hi, smem, 0))
PROBE_K(k_gateup, phase_gateup(p, smem))
#endif
#ifdef RESOURCE_PROBE
PROBE_K(k_mixers, phase_mixers(p, p.ph_lo, smem, 3, 0, 0))
__global__ void __launch_bounds__(256, 2) k_nomix(Params p) {
  char* smem = dyn_smem;
  cg::grid_group grid = cg::this_grid();
  for (int ph = p.ph_lo; ph < p.ph_hi; ++ph) { if ((ph - 1) % 9 != 2) run_phase(p, ph, smem); if (ph + 1 < p.ph_hi) grid.sync(); }
}
#endif
```
